# Optimizing an MI355X kernel written in HIP

```python
import jax, jax.numpy as jnp
from jax import lax
import numpy as np

D_MODEL = 1024
BATCH = 2
SEQ = 8192
DEPTH = 1

HEAD_DIM = 64
ATTN_GROUPS = ((128, 1), (512, 4), (2048, 16))
ATTN_HEADS_PER_GROUP = 4
ATTN_HEADS = ATTN_HEADS_PER_GROUP * len(ATTN_GROUPS)
ATTN_WIDTH = ATTN_HEADS * HEAD_DIM
ATTN_OUT_WIDTH = ATTN_HEADS_PER_GROUP * HEAD_DIM
ATTN_BLOCK = 128
ROPE_THETA = 500000.0
ROPE_DIM = HEAD_DIM // 4
RWKV_HEADS = D_MODEL // HEAD_DIM
RWKV_WIDTH = RWKV_HEADS * HEAD_DIM
DECAY_LORA = 64
ICLR_LORA = 64
GATE_LORA = 128
D_FF = 4 * D_MODEL
NORM_EPS = 1e-6
GN_EPS = 64e-5
NEG_INF = -1e30
SPLITS = (ATTN_WIDTH, ATTN_WIDTH, ATTN_WIDTH,
          RWKV_WIDTH, RWKV_WIDTH, RWKV_WIDTH,
          DECAY_LORA, ICLR_LORA, GATE_LORA,
          D_MODEL, D_MODEL)
ATTN_QKV_WIDTH = 3 * ATTN_WIDTH
SHIFT_WIDTH = 3 * RWKV_WIDTH + DECAY_LORA + ICLR_LORA + GATE_LORA
IN_WIDTH = sum(SPLITS)

kernel_name = "hybrid_dilated_attn_rwkv7_block"


def rms_norm(t, gain):
    t32 = t.astype(jnp.float32)
    y = t32 * lax.rsqrt(jnp.mean(t32 * t32, axis=-1, keepdims=True) + NORM_EPS)
    return (y * gain.astype(jnp.float32)).astype(t.dtype)


def partial_rope(t, positions):
    half = ROPE_DIM // 2
    inv = ROPE_THETA ** (-jnp.arange(half, dtype=jnp.float32) * 2.0 / ROPE_DIM)
    ang = positions.astype(jnp.float32)[..., None] * inv
    cos = jnp.cos(ang)[:, :, None, :]
    sin = jnp.sin(ang)[:, :, None, :]
    t32 = t.astype(jnp.float32)
    x1 = t32[..., :half]
    x2 = t32[..., half:ROPE_DIM]
    out = jnp.concatenate([x1 * cos - x2 * sin, x1 * sin + x2 * cos, t32[..., ROPE_DIM:]], axis=-1)
    return out.astype(t.dtype)


def dilated_band_attention(q, k, v, dilation, span):
    B, S, H, Dh = q.shape
    unit = dilation * ATTN_BLOCK
    Sp = -(-S // unit) * unit
    L = Sp // dilation
    nb = L // ATTN_BLOCK

    def to_blocks(t):
        t = jnp.pad(t.astype(jnp.float32), ((0, 0), (0, Sp - S), (0, 0), (0, 0)))
        t = t.reshape(B, L, dilation, H, Dh).transpose(0, 2, 1, 3, 4)
        return t.reshape(B, dilation, nb, ATTN_BLOCK, H, Dh)

    qb, kb, vb = to_blocks(q), to_blocks(k), to_blocks(v)

    def with_prev(t):
        prev = jnp.pad(t[:, :, :-1], ((0, 0), (0, 0), (1, 0), (0, 0), (0, 0), (0, 0)))
        return jnp.concatenate([prev, t], axis=3)

    kw, vw = with_prev(kb), with_prev(vb)
    s = jnp.einsum('bdnqhe,bdnkhe->bdnhqk', qb, kw) * (HEAD_DIM ** -0.5)
    qi = jnp.arange(ATTN_BLOCK)[:, None]
    kj = jnp.arange(2 * ATTN_BLOCK)[None, :]
    lag = qi + ATTN_BLOCK - kj
    band = (lag >= 0) & (lag <= span)
    has_prev = (jnp.arange(nb) > 0)[:, None, None] | (kj >= ATTN_BLOCK)[None]
    mask = band[None] & has_prev
    s = jnp.where(mask[None, None, :, None], s, NEG_INF)
    m = jnp.max(s, axis=-1, keepdims=True)
    p = jnp.exp(s - m)
    l = jnp.sum(p, axis=-1, keepdims=True)
    o = jnp.einsum('bdnhqk,bdnkhe->bdnqhe', p / l, vw)
    lse = jnp.swapaxes((m + jnp.log(l))[..., 0], -1, -2)

    def from_blocks(t):
        t = t.reshape((B, dilation, L) + t.shape[4:])
        t = jnp.swapaxes(t, 1, 2)
        return t.reshape((B, Sp) + t.shape[3:])[:, :S]

    return from_blocks(o), from_blocks(lse)


def dilated_attention_mixer(q, k, v, positions):
    B, S = q.shape[:2]
    q = partial_rope(q, positions)
    k = partial_rope(k, positions)
    outs, lses = [], []
    for g, (window, dilation) in enumerate(ATTN_GROUPS):
        sl = slice(g * ATTN_HEADS_PER_GROUP, (g + 1) * ATTN_HEADS_PER_GROUP)
        o, lse = dilated_band_attention(q[:, :, sl], k[:, :, sl], v[:, :, sl], dilation, window // dilation)
        outs.append(o)
        lses.append(lse)
    o = jnp.stack(outs)
    w = jax.nn.softmax(jnp.stack(lses), axis=0)
    out = jnp.sum(w[..., None] * o, axis=0)
    return out.reshape(B, S, ATTN_OUT_WIDTH).astype(q.dtype)


def token_shift(u, mu):
    prev = jnp.pad(u, ((0, 0), (1, 0), (0, 0)))[:, :-1]
    return u + (prev - u) * mu


def wkv7_scan(r, w, k, v, a, b):
    B, S, H, N = r.shape
    xs = tuple(jnp.moveaxis(t, 1, 0) for t in (r, w, k, v, a, b))

    def step(state, inp):
        r_t, w_t, k_t, v_t, a_t, b_t = inp
        sa = jnp.einsum('bhvk,bhk->bhv', state, a_t)
        state = (state * w_t[:, :, None, :] + sa[..., None] * b_t[:, :, None, :]
                 + v_t[..., None] * k_t[:, :, None, :])
        return state, jnp.einsum('bhvk,bhk->bhv', state, r_t)

    s0 = jnp.zeros((B, H, N, N), jnp.float32)
    _, ys = lax.scan(step, s0, xs)
    return jnp.moveaxis(ys, 0, 1)


def rwkv7_mixer(r, k, v, dw, da, dg, w0, w2, a0, a2, g2, k_k, k_a, r_k, gn_w, gn_b):
    B, S, C = r.shape
    H, N = RWKV_HEADS, HEAD_DIM
    f32 = jnp.float32
    w_log = -jax.nn.softplus(-(w0 + jnp.tanh(dw) @ w2).astype(f32)) - 0.5
    decay = jnp.exp(-jnp.exp(w_log))
    a = jax.nn.sigmoid((a0 + da @ a2).astype(f32))
    g = (jax.nn.sigmoid(dg) @ g2).astype(f32)
    kk = (k * k_k).astype(f32).reshape(B, S, H, N)
    kk = kk / jnp.maximum(jnp.sqrt(jnp.sum(kk * kk, axis=-1, keepdims=True)), 1e-12)
    k = k.astype(f32) * (1.0 + (a - 1.0) * k_a.astype(f32))
    heads = lambda t: t.astype(f32).reshape(B, S, H, N)
    rh, kh, vh, wh, ah = heads(r), heads(k), heads(v), heads(decay), heads(a)
    y = wkv7_scan(rh, wh, kh, vh, -kk, kk * ah)
    mu = jnp.mean(y, axis=-1, keepdims=True)
    var = jnp.mean(jnp.square(y - mu), axis=-1, keepdims=True)
    y = ((y - mu) * lax.rsqrt(var + GN_EPS)).reshape(B, S, C) * gn_w + gn_b
    bonus = jnp.sum(rh * kh * r_k.astype(f32), axis=-1, keepdims=True) * vh
    y = y + bonus.reshape(B, S, C)
    return (y * g).astype(r.dtype)


def setup_inputs(seed: int = 0) -> dict:
    key = jax.random.key(seed)
    ks = jax.random.split(key, 32)
    f32 = jnp.float32
    L, D = DEPTH, D_MODEL
    nrm = lambda kk, shape, scale: jax.random.normal(kk, shape, f32) * scale
    x = nrm(ks[0], (BATCH, SEQ, D), 1.0)
    c = nrm(ks[1], (BATCH, D), 1.0)
    offset = jax.random.randint(ks[2], (BATCH, 1), 0, 4096, dtype=jnp.int32)
    positions = offset + jnp.arange(SEQ, dtype=jnp.int32)[None, :]
    return {
        "x": x,
        "c": c,
        "positions": positions,
        "ada_w": nrm(ks[3], (L, D, 6 * D), 0.5 * D ** -0.5),
        "ada_b": nrm(ks[4], (L, 6 * D), 0.02),
        "norm_mix_pre": 1.0 + nrm(ks[5], (L, D), 0.05),
        "norm_mix_post": 1.0 + nrm(ks[6], (L, D), 0.05),
        "norm_ffn_pre": 1.0 + nrm(ks[7], (L, D), 0.05),
        "norm_ffn_post": 1.0 + nrm(ks[8], (L, D), 0.05),
        "w_in": nrm(ks[9], (L, D, IN_WIDTH), D ** -0.5),
        "shift_mu": jax.random.uniform(ks[10], (L, SHIFT_WIDTH), f32),
        "decay_w0": jax.random.uniform(ks[11], (L, RWKV_WIDTH), f32, -6.0, 1.0),
        "decay_w2": nrm(ks[12], (L, DECAY_LORA, RWKV_WIDTH), DECAY_LORA ** -0.5),
        "iclr_a0": nrm(ks[13], (L, RWKV_WIDTH), 0.1),
        "iclr_a2": nrm(ks[14], (L, ICLR_LORA, RWKV_WIDTH), ICLR_LORA ** -0.5),
        "gate_g2": nrm(ks[15], (L, GATE_LORA, RWKV_WIDTH), GATE_LORA ** -0.5),
        "k_k": 0.85 + nrm(ks[16], (L, RWKV_WIDTH), 0.05),
        "k_a": 1.0 + nrm(ks[17], (L, RWKV_WIDTH), 0.05),
        "r_k": nrm(ks[18], (L, RWKV_HEADS, HEAD_DIM), 0.1),
        "gn_w": 1.0 + nrm(ks[19], (L, RWKV_WIDTH), 0.05),
        "gn_b": nrm(ks[20], (L, RWKV_WIDTH), 0.02),
        "w_branch": jnp.concatenate([nrm(ks[21], (L, ATTN_OUT_WIDTH, D), ATTN_OUT_WIDTH ** -0.5),
                                     nrm(ks[22], (L, RWKV_WIDTH, D), RWKV_WIDTH ** -0.5)], axis=1),
        "w_out": nrm(ks[23], (L, D, D), D ** -0.5),
        "w_ff1": nrm(ks[24], (L, D, D_FF), D ** -0.5),
        "w_ff2": nrm(ks[25], (L, D_FF, D), D_FF ** -0.5),
    }


def reference(x, c, positions, ada_w, ada_b, norm_mix_pre, norm_mix_post, norm_ffn_pre,
              norm_ffn_post, w_in, shift_mu, decay_w0, decay_w2, iclr_a0, iclr_a2, gate_g2,
              k_k, k_a, r_k, gn_w, gn_b, w_branch, w_out, w_ff1, w_ff2):
    B, S, D = x.shape
    for l in range(DEPTH):
        mod = jax.nn.silu(c) @ ada_w[l] + ada_b[l]
        sh1, sc1, gt1, sh2, sc2, gt2 = [m[:, None, :] for m in jnp.split(mod, 6, axis=-1)]

        h = rms_norm(x, norm_mix_pre[l]) * (1.0 + sc1) + sh1
        proj = h @ w_in[l]
        attn_part = proj[..., :ATTN_QKV_WIDTH]
        rwkv_part = token_shift(proj[..., ATTN_QKV_WIDTH:ATTN_QKV_WIDTH + SHIFT_WIDTH], shift_mu[l])
        gate_part = proj[..., ATTN_QKV_WIDTH + SHIFT_WIDTH:]
        q, k, v = [t.reshape(B, S, ATTN_HEADS, HEAD_DIM) for t in jnp.split(attn_part, 3, axis=-1)]
        cuts = np.cumsum([RWKV_WIDTH, RWKV_WIDTH, RWKV_WIDTH, DECAY_LORA, ICLR_LORA])
        r_r, r_k_, r_v, dw, da, dg = jnp.split(rwkv_part, cuts, axis=-1)
        g_attn, g_rwkv = jnp.split(gate_part, 2, axis=-1)

        o_attn = dilated_attention_mixer(q, k, v, positions)
        o_rwkv = rwkv7_mixer(r_r, r_k_, r_v, dw, da, dg, decay_w0[l], decay_w2[l], iclr_a0[l],
                             iclr_a2[l], gate_g2[l], k_k[l], k_a[l], r_k[l], gn_w[l], gn_b[l])
        wb = w_branch[l]
        merged = (jax.nn.sigmoid(g_attn) * (o_attn @ wb[:ATTN_OUT_WIDTH])
                  + jax.nn.sigmoid(g_rwkv) * (o_rwkv @ wb[ATTN_OUT_WIDTH:]))
        mix_out = merged @ w_out[l]
        x = (x + gt1 * rms_norm(mix_out, norm_mix_post[l])).astype(x.dtype)

        h = rms_norm(x, norm_ffn_pre[l]) * (1.0 + sc2) + sh2
        f = jnp.square(jax.nn.relu(h @ w_ff1[l])) @ w_ff2[l]
        x = (x + gt2 * rms_norm(f, norm_ffn_post[l])).astype(x.dtype)
    return x
```

```cpp
#include <hip/hip_runtime.h>
#include <cstdio>
#include <cstdint>

namespace pg8 {
#define PG8_LAS __attribute__((address_space(3)))
typedef unsigned short bf16_t;
typedef short bf16x8 __attribute__((ext_vector_type(8)));
typedef float f32x4 __attribute__((ext_vector_type(4)));
typedef unsigned u32x4 __attribute__((ext_vector_type(4)));
constexpr int BM = 256, BK = 64, HALF = 128, HTB = HALF * BK * 2  , STAGE_BYTES = 8 * HTB, NXCD = 8, WGM = 4;

__host__ __device__ __forceinline__ int lds_byte(int r, int c) { const int st = (r >> 4) * 2 + (c >> 5), rr = r & 15, cc = c & 31, ob = rr * 64 + cc * 2; return st * 1024 + (ob ^ (((ob >> 9) & 1) << 5)); }
__host__ __device__ __forceinline__ void stage_rc(int b, int& R, int& C) { const int st = b / 1024, sb = b % 1024, swz = sb ^ (((sb >> 9) & 1) << 5); R = (st >> 1) * 16 + swz / 64; C = (st & 1) * 32 + (swz % 64) / 2; }
__host__ __device__ __forceinline__ int perm32(int rho) { const int n = rho >> 4, i = rho & 15; return 8 * (i >> 2) + 4 * n + (i & 3); }

struct Unit { int pm, pn; };
struct Gemm { const bf16_t* A; const bf16_t* Bt; int M, N, K, lda, ldb; };

struct StaticOrder {
    int nM, nN, nwg, G, c;
    __host__ __device__ void init(int M, int N, int G_, int c_) { nM = M / BM; nN = N / BM; nwg = nM * nN; G = G_; c = c_; }
    __host__ __device__ bool next(int i, Unit& u) const {
        const long L = (long)i * G + c; if (L >= nwg) return false;
        int wgid = (int)L; { const int q = nwg / NXCD, r = nwg % NXCD, xcd = wgid % NXCD, off = wgid / NXCD; wgid = (xcd < r ? xcd * (q + 1) : r * (q + 1) + (xcd - r) * q) + off; }
        const int nig = WGM * nN, gid = wgid / nig, fm = gid * WGM, gsz = (nM - fm) < WGM ? (nM - fm) : WGM;
        u.pm = fm + ((wgid % nig) % gsz); u.pn = (wgid % nig) / gsz; return true;
    }
    __device__ __forceinline__ void a_ready(const Unit&) const {}
    __device__ __forceinline__ void done(const Unit&) const {}
};

template <class F> struct EpiG {
    static constexpr bool PERM = true, AFTER_DRAIN = false;
    F f;
    __device__ __forceinline__ void operator()(const f32x4 (&acc)[2][2][4][2], const Unit& u, int wr, int wc, int fr, int fq) const {
        const int row0 = u.pm * BM + wr * 64 + fr, col0 = u.pn * BM + wc * 32 + 8 * fq;
#pragma unroll
        for (int ai = 0; ai < 2; ++ai)
#pragma unroll
            for (int m = 0; m < 4; ++m)
#pragma unroll
                for (int bj = 0; bj < 2; ++bj) f(row0 + ai * HALF + m * 16, col0 + bj * HALF, acc[ai][bj][m][0], acc[ai][bj][m][1]);
    }
};

template <class Epi, class Sched, bool ALIGN_EPI = false, bool SP2 = false>
__device__ __forceinline__ void gemm_phase(PG8_LAS unsigned char* lds, const Gemm g, const Sched& S, const Epi& E) {
    int tid_ = threadIdx.x; asm volatile("" : "+v"(tid_));
    const int tid = tid_, wid = __builtin_amdgcn_readfirstlane(tid >> 6), lane = tid & 63, wr = wid >> 2, wc = wid & 3, fr = lane & 15, fq = lane >> 4;
    const int K = g.K, nt = K / BK;
    unsigned voffA[2], voffB[2];
#pragma unroll
    for (int i = 0; i < 2; ++i) { int R, C; stage_rc(tid * 16 + i * 8192, R, C); const int Rb = Epi::PERM ? ((R & ~31) + perm32(R & 31)) : R;
        voffA[i] = (unsigned)(R * g.lda + C) * 2u; voffB[i] = (unsigned)(Rb * g.ldb + C) * 2u; }
    const size_t kstep = (size_t)(BK * 2);
    const size_t hstepA = (size_t)HALF * g.lda * 2, hstepB = (size_t)HALF * g.ldb * 2;
    const size_t tstepA = 2 * hstepA, tstepB = 2 * hstepB;
    const unsigned ldsw = (unsigned)wid * 1024u;
    const int aoff = lds_byte(wr * 64 + fr, fq * 8), boff = lds_byte(wc * 32 + fr, fq * 8);
#define PG8_SA(b, h) (((b) * 2 + (h)) * HTB)
#define PG8_SB(b, h) ((4 + (b) * 2 + (h)) * HTB)
#define PG8_STAGE(bufoff, gbase, voff) do { _Pragma("unroll") for (int _i = 0; _i < 2; ++_i) \
        __builtin_amdgcn_global_load_lds((const unsigned*)((const char*)(gbase) + (voff)[_i]), (PG8_LAS unsigned*)(lds + (bufoff) + ldsw + _i * 8192), 16, 0, 0); } while (0)
#define PG8_LDA(dst, b, h) do { _Pragma("unroll") for (int m = 0; m < 4; ++m) _Pragma("unroll") for (int k = 0; k < 2; ++k) dst[m][k] = *(const PG8_LAS bf16x8*)(lds + PG8_SA(b, h) + aoff + m * 2048 + k * 1024); } while (0)
#define PG8_LDB(dst, b, h) do { _Pragma("unroll") for (int n = 0; n < 2; ++n) _Pragma("unroll") for (int k = 0; k < 2; ++k) dst[n][k] = *(const PG8_LAS bf16x8*)(lds + PG8_SB(b, h) + boff + n * 2048 + k * 1024); } while (0)
#define PG8_MMA(ai, bj, At, Bt) do { __builtin_amdgcn_s_setprio(1); _Pragma("unroll") for (int m = 0; m < 4; ++m) _Pragma("unroll") for (int n = 0; n < 2; ++n) _Pragma("unroll") for (int k = 0; k < 2; ++k) \
        acc[ai][bj][m][n] = __builtin_amdgcn_mfma_f32_16x16x32_bf16(Bt[n][k], At[m][k], acc[ai][bj][m][n], 0, 0, 0); __builtin_amdgcn_s_setprio(0); } while (0)
#define PG8_WAIT_V(n) asm volatile("s_waitcnt vmcnt(" #n ")" ::: "memory")
#define PG8_WAIT_L(n) asm volatile("s_waitcnt lgkmcnt(" #n ")" ::: "memory")
#define PG8_BAR __builtin_amdgcn_s_barrier()
#define PG8_SCHED __builtin_amdgcn_sched_barrier(0)
    Unit cur, nxt; int ui = 0;
    if (!S.next(0, cur)) return;
    f32x4 acc[2][2][4][2];
#pragma unroll
    for (int a = 0; a < 2; ++a)
#pragma unroll
        for (int b = 0; b < 2; ++b)
#pragma unroll
            for (int m = 0; m < 4; ++m)
#pragma unroll
                for (int n = 0; n < 2; ++n) acc[a][b][m][n] = (f32x4){0.f, 0.f, 0.f, 0.f};
    bf16x8 At[4][2], B0[2][2], B1[2][2];
    const char* cA = (const char*)g.A + (size_t)cur.pm * tstepA; const char* cB = (const char*)g.Bt + (size_t)cur.pn * tstepB;
    S.a_ready(cur);
    if constexpr (SP2) {
        PG8_STAGE(PG8_SB(0, 0), cB, voffB); PG8_STAGE(PG8_SB(0, 1), cB + hstepB, voffB); PG8_STAGE(PG8_SA(0, 0), cA, voffA); PG8_STAGE(PG8_SA(0, 1), cA + hstepA, voffA);
        if (wr == 1) PG8_BAR;
        PG8_WAIT_V(2); PG8_BAR;
        PG8_STAGE(PG8_SB(1, 0), cB + kstep, voffB); PG8_STAGE(PG8_SA(1, 0), cA + kstep, voffA); PG8_STAGE(PG8_SB(1, 1), cB + hstepB + kstep, voffB);
        PG8_WAIT_V(6); PG8_BAR;
    } else {
        PG8_STAGE(PG8_SB(0, 0), cB, voffB); PG8_STAGE(PG8_SA(0, 0), cA, voffA); PG8_STAGE(PG8_SB(0, 1), cB + hstepB, voffB); PG8_STAGE(PG8_SA(0, 1), cA + hstepA, voffA);
        if (wr == 1) PG8_BAR;
        PG8_WAIT_V(4); PG8_BAR;
        PG8_STAGE(PG8_SB(1, 0), cB + kstep, voffB); PG8_STAGE(PG8_SA(1, 0), cA + kstep, voffA); PG8_STAGE(PG8_SB(1, 1), cB + hstepB + kstep, voffB);
        PG8_WAIT_V(6); PG8_BAR;
    }
    for (;;) {
        const bool has_next = S.next(ui + 1, nxt);
        const char* nA = has_next ? (const char*)g.A + (size_t)nxt.pm * tstepA : cA; const char* nB = has_next ? (const char*)g.Bt + (size_t)nxt.pn * tstepB : cB;
        for (int t = 0; t < nt; t += 2) {
            const bool last = (t == nt - 2);
            const char* a1 = cA + (size_t)(t + 1) * kstep;
            const char* a2 = last ? nA : cA + (size_t)(t + 2) * kstep; const char* b2 = last ? nB : cB + (size_t)(t + 2) * kstep;
            const char* a3 = a2 + kstep; const char* b3 = b2 + kstep;
            if (last && has_next) S.a_ready(nxt);
            if constexpr (SP2) {
            PG8_LDB(B0, 0, 0); PG8_LDB(B1, 0, 1); PG8_SCHED; PG8_LDA(At, 0, 0); PG8_STAGE(PG8_SA(1, 1), a1 + hstepA, voffA);
            PG8_WAIT_V(8); PG8_WAIT_L(0); PG8_BAR; PG8_MMA(0, 0, At, B0); PG8_MMA(0, 1, At, B1); PG8_BAR; PG8_SCHED;
            PG8_LDA(At, 0, 1); PG8_STAGE(PG8_SB(0, 0), b2, voffB); PG8_STAGE(PG8_SB(0, 1), b2 + hstepB, voffB); PG8_STAGE(PG8_SA(0, 0), a2, voffA);
            PG8_WAIT_V(8); PG8_WAIT_L(0); PG8_BAR; PG8_MMA(1, 0, At, B0); PG8_MMA(1, 1, At, B1); PG8_BAR; PG8_SCHED;
            PG8_LDB(B0, 1, 0); PG8_LDB(B1, 1, 1); PG8_SCHED; PG8_LDA(At, 1, 0); PG8_STAGE(PG8_SA(0, 1), a2 + hstepA, voffA);
            PG8_WAIT_V(8); PG8_WAIT_L(0); PG8_BAR; PG8_MMA(0, 0, At, B0); PG8_MMA(0, 1, At, B1); PG8_BAR; PG8_SCHED;
            PG8_LDA(At, 1, 1); PG8_STAGE(PG8_SB(1, 0), b3, voffB); PG8_STAGE(PG8_SB(1, 1), b3 + hstepB, voffB); PG8_STAGE(PG8_SA(1, 0), a3, voffA);
            PG8_WAIT_V(8); PG8_WAIT_L(0); PG8_BAR; PG8_MMA(1, 0, At, B0); PG8_MMA(1, 1, At, B1); PG8_BAR; PG8_SCHED;
            } else {
            PG8_LDB(B0, 0, 0); PG8_SCHED; PG8_LDA(At, 0, 0); PG8_STAGE(PG8_SA(1, 1), a1 + hstepA, voffA);
            PG8_WAIT_L(8); PG8_BAR; PG8_WAIT_L(0); PG8_MMA(0, 0, At, B0); PG8_BAR; PG8_SCHED;
            PG8_LDB(B1, 0, 1); PG8_STAGE(PG8_SB(0, 0), b2, voffB);
            PG8_BAR; PG8_WAIT_L(0); PG8_MMA(0, 1, At, B1); PG8_BAR;
            PG8_LDA(At, 0, 1); PG8_STAGE(PG8_SA(0, 0), a2, voffA);
            PG8_BAR; PG8_WAIT_L(0); PG8_MMA(1, 0, At, B0); PG8_BAR; PG8_SCHED;
            PG8_STAGE(PG8_SB(0, 1), b2 + hstepB, voffB);
            PG8_WAIT_V(6); PG8_BAR; PG8_MMA(1, 1, At, B1); PG8_BAR;
            PG8_LDB(B0, 1, 0); PG8_SCHED; PG8_LDA(At, 1, 0); PG8_STAGE(PG8_SA(0, 1), a2 + hstepA, voffA);
            PG8_WAIT_L(8); PG8_BAR; PG8_WAIT_L(0); PG8_MMA(0, 0, At, B0); PG8_BAR; PG8_SCHED;
            PG8_LDB(B1, 1, 1); PG8_STAGE(PG8_SB(1, 0), b3, voffB);
            PG8_BAR; PG8_WAIT_L(0); PG8_MMA(0, 1, At, B1); PG8_BAR;
            PG8_LDA(At, 1, 1); PG8_STAGE(PG8_SA(1, 0), a3, voffA);
            PG8_BAR; PG8_WAIT_L(0); PG8_MMA(1, 0, At, B0); PG8_BAR; PG8_SCHED;
            PG8_STAGE(PG8_SB(1, 1), b3 + hstepB, voffB);
            PG8_WAIT_V(6); PG8_BAR; PG8_MMA(1, 1, At, B1); PG8_BAR;
            }
        }
        if constexpr (ALIGN_EPI) { if (wr == 0) PG8_BAR; }
        if constexpr (!Epi::AFTER_DRAIN) { E(acc, cur, wr, wc, fr, fq); S.done(cur); }
        if (!has_next) break;
#pragma unroll
        for (int a = 0; a < 2; ++a)
#pragma unroll
            for (int b = 0; b < 2; ++b)
#pragma unroll
                for (int m = 0; m < 4; ++m)
#pragma unroll
                    for (int n = 0; n < 2; ++n) acc[a][b][m][n] = (f32x4){0.f, 0.f, 0.f, 0.f};
        cur = nxt; cA = nA; cB = nB; ++ui;
        if constexpr (ALIGN_EPI) { if (wr == 1) PG8_BAR; }
    }
    PG8_WAIT_V(0);
    if constexpr (!ALIGN_EPI) { if (wr == 0) PG8_BAR; }
    PG8_BAR;
    if constexpr (Epi::AFTER_DRAIN) { E.fused(acc, cur, wr, wc, fr, fq, lds, wid, lane); S.done(cur); }
#undef PG8_SA
#undef PG8_SB
#undef PG8_STAGE
#undef PG8_LDA
#undef PG8_LDB
#undef PG8_MMA
#undef PG8_WAIT_V
#undef PG8_WAIT_L
#undef PG8_BAR
#undef PG8_SCHED
}
}

#define GAS __attribute__((address_space(1)))
#define LAS __attribute__((address_space(3)))
typedef unsigned short bf16_t;
typedef unsigned u32x4 __attribute__((ext_vector_type(4)));
typedef unsigned u32x2 __attribute__((ext_vector_type(2)));
typedef float f32x4 __attribute__((ext_vector_type(4)));
typedef short bf16x8 __attribute__((ext_vector_type(8)));
typedef short s16x4 __attribute__((ext_vector_type(4)));

constexpr int NB = 2, S = 8192, D = 1024, M = NB * S, FF = 4096;
constexpr int NIN = 7680;
constexpr float NORM_EPS = 1e-6f, GN_EPS = 64e-5f;
constexpr size_t MiB = 1u << 20;
constexpr size_t WS_MOD = 0;
constexpr size_t WS_CTL = 512 * 1024, CTL_BYTES = 49152;
constexpr size_t WS_XB1 = 3 * MiB, WS_XB2 = 5 * MiB;
constexpr size_t WS_ROPE = 1 * MiB;
constexpr size_t WS_LSE = 2 * MiB;
constexpr size_t WS_WIN = 3 * MiB;
constexpr size_t WS_WFF1 = 18 * MiB;
constexpr size_t WS_WFF2 = 26 * MiB;
constexpr size_t WS_WBR = 34 * MiB;
constexpr size_t WS_WOUT = 37 * MiB;
constexpr size_t WS_WL1 = 39 * MiB;
constexpr size_t WS_WL2 = 39 * MiB + 512 * 1024;
constexpr size_t WS_H = 40 * MiB;
constexpr size_t WS_QKV = 72 * MiB;
constexpr size_t WS_RKV = 144 * MiB;
constexpr size_t WS_LRAW = 240 * MiB;
constexpr size_t WS_LA = 248 * MiB;
constexpr size_t WS_END = 256 * MiB;
constexpr size_t WS_O = WS_H;
constexpr size_t WS_Y = WS_H;
constexpr size_t WS_LW = WS_QKV;
constexpr size_t WS_AA = WS_QKV + 32 * MiB;
constexpr size_t WS_GG = WS_QKV;
constexpr size_t WS_ORW = 72 * MiB;
constexpr size_t WS_OATT = WS_LRAW;
constexpr size_t WS_MRG = WS_RKV;
constexpr size_t WS_MERGED = WS_RKV + 64 * MiB;
constexpr size_t WS_MIX = WS_H;
constexpr size_t WS_H2 = 176 * MiB;
constexpr size_t WS_FFH = WS_H;
constexpr size_t WS_F = 168 * MiB;
constexpr size_t WS_G1P = 72 * MiB;
constexpr size_t WS_SPP = 104 * MiB;
constexpr size_t WS_WC = 136 * MiB;
constexpr int LDS_BYTES = 147456;

__device__ __forceinline__ float bf2f(unsigned v) { return __uint_as_float(v << 16); }
__device__ __forceinline__ unsigned f2bf(float f) { unsigned u = __float_as_uint(f); return (u + 0x7fffu + ((u >> 16) & 1u)) >> 16; }
typedef float f32x2_t __attribute__((ext_vector_type(2))); typedef __bf16 bf16x2_t __attribute__((ext_vector_type(2)));
__device__ __forceinline__ unsigned pk2(float lo, float hi) { const f32x2_t v = {lo, hi}; const bf16x2_t b = __builtin_convertvector(v, bf16x2_t); return __builtin_bit_cast(unsigned, b); }
__device__ __forceinline__ void unpack8(const u32x4 v, float* f) {
    f[0] = bf2f(v.x & 0xffffu); f[1] = __uint_as_float(v.x & 0xffff0000u); f[2] = bf2f(v.y & 0xffffu); f[3] = __uint_as_float(v.y & 0xffff0000u);
    f[4] = bf2f(v.z & 0xffffu); f[5] = __uint_as_float(v.z & 0xffff0000u); f[6] = bf2f(v.w & 0xffffu); f[7] = __uint_as_float(v.w & 0xffff0000u);
}
__device__ __forceinline__ u32x4 pack8(const float* f) { u32x4 o; o.x = pk2(f[0], f[1]); o.y = pk2(f[2], f[3]); o.z = pk2(f[4], f[5]); o.w = pk2(f[6], f[7]); return o; }
__device__ __forceinline__ float sigmoidf_(float x) { return __builtin_amdgcn_rcpf(1.0f + __expf(-x)); }
template <int CTRL> __device__ __forceinline__ float dppf(float v) { return __uint_as_float((unsigned)__builtin_amdgcn_update_dpp(0, (int)__float_as_uint(v), CTRL, 0xF, 0xF, true)); }
__device__ __forceinline__ float red8(float v) { v += dppf<0xB1>(v); v += dppf<0x4E>(v); v += dppf<0x141>(v); return v; }
__device__ __forceinline__ float red16(float v) { v = red8(v); v += dppf<0x140>(v); return v; }
__device__ __forceinline__ float wave_sum(float v) {
#pragma unroll
    for (int o = 1; o < 64; o <<= 1) v += __shfl_xor(v, o);
    return v;
}

struct Params { const float* in[25]; float* out; unsigned char* ws; };
typedef const Params __attribute__((address_space(4)))* CP;
__device__ __forceinline__ CP get_params() { CP q = (CP)__builtin_amdgcn_kernarg_segment_ptr(); asm volatile("" : "+s"(q)); return q; }
__device__ __forceinline__ int fresh_tid() { int t = threadIdx.x; asm volatile("" : "+v"(t)); return t; }

#define XB_TMO      128
#define XB_XCNT(j)  (256  + 64 * (j))
#define XB_XSUB(j)  (1280 + 64 * (j))
#define XB_XGEN(j)  (2304 + 64 * (j))
#define XB_TOP      3328
#define XB_TOPGEN   3392
#define XCD_BAR_WORDS 3456
#define XB_SPIN_CAP (1u << 18)

__device__ __forceinline__ unsigned xb_ld(unsigned* p)              { return __hip_atomic_load(p, __ATOMIC_RELAXED, __HIP_MEMORY_SCOPE_AGENT); }
__device__ __forceinline__ unsigned xb_add(unsigned* p, unsigned v) { return __hip_atomic_fetch_add(p, v, __ATOMIC_RELAXED, __HIP_MEMORY_SCOPE_AGENT); }
__device__ __forceinline__ unsigned xb_xcc_id() { return (unsigned)__builtin_amdgcn_s_getreg((3 << 11) | 20) & 0xFu; }
#define XB_SPIN(cond, bar) do { unsigned _sp = 0; while (cond) { __builtin_amdgcn_s_sleep(1); \
    if ((++_sp & 255u) == 0u) { if (xb_ld(&(bar)[XB_TMO])) break; if (_sp > XB_SPIN_CAP) { atomicAdd(&(bar)[XB_TMO], 1u); break; } } } } while (0)

struct XcdBarrier {
    unsigned* bar; unsigned x;
    volatile LAS unsigned* st;
};

__device__ __forceinline__ XcdBarrier xcd_barrier_post(unsigned* bar, volatile LAS unsigned* st) {
    XcdBarrier b; b.bar = bar; b.x = xb_xcc_id(); b.st = st;
    if (threadIdx.x == 0) (void)xb_add(&bar[XB_XCNT(b.x)], 1u);
    return b;
}
__device__ __forceinline__ void xcd_barrier_complete(unsigned* bar, unsigned x, unsigned& nloc, unsigned& nx) {
    const unsigned G = gridDim.x * gridDim.y * gridDim.z;
    unsigned sum, cnt, mine, sp = 0u;
    for (;;) {
        sum = 0u; cnt = 0u; mine = 0u;
#pragma unroll
        for (unsigned j = 0; j < 16; ++j) { const unsigned c = xb_ld(&bar[XB_XCNT(j)]); sum += c; cnt += (c > 0u) ? 1u : 0u; mine = (j == x) ? c : mine; }
        if (sum == G) break;
        __builtin_amdgcn_s_sleep(1);
        if ((++sp & 255u) == 0u) { if (xb_ld(&bar[XB_TMO])) break; if (sp > XB_SPIN_CAP) { atomicAdd(&bar[XB_TMO], 1u); break; } }
    }
    nloc = mine > 0u ? mine : 1u; nx = cnt > 0u ? cnt : 1u;
}

__device__ __forceinline__ void xcd_barrier(const XcdBarrier& b) {
    asm volatile("s_waitcnt vmcnt(0)" ::: "memory");
    __syncthreads();
    if (threadIdx.x == 0) {
        unsigned* bar = b.bar;
        __builtin_amdgcn_s_waitcnt(0);
        unsigned nloc = b.st[0], nx = b.st[1];
        if (nloc == 0u) { xcd_barrier_complete(bar, b.x, nloc, nx); b.st[0] = nloc; b.st[1] = nx; }
        const unsigned old = xb_add(&bar[XB_XSUB(b.x)], 1u);
        const unsigned gen = old / nloc;
        if (old + 1u == (gen + 1u) * nloc) {
            __builtin_amdgcn_fence(__ATOMIC_RELEASE, "agent");
            asm volatile("s_waitcnt vmcnt(0)" ::: "memory");
            const unsigned og = xb_add(&bar[XB_TOP], 1u);
            const unsigned tg = og / nx;
            if (og + 1u == (tg + 1u) * nx) xb_add(&bar[XB_TOPGEN], 1u);
            else XB_SPIN(xb_ld(&bar[XB_TOPGEN]) == tg, bar);
            __builtin_amdgcn_fence(__ATOMIC_ACQUIRE, "agent");
            xb_add(&bar[XB_XGEN(b.x)], 1u);
            asm volatile("s_waitcnt vmcnt(0)" ::: "memory");
        } else {
            XB_SPIN(xb_ld(&bar[XB_XGEN(b.x)]) == gen, bar);
            __builtin_amdgcn_fence(__ATOMIC_ACQUIRE, "agent");
            asm volatile("s_waitcnt vmcnt(0)" ::: "memory");
        }
    }
    __syncthreads();
}


__device__ __forceinline__ void st8bf(bf16_t* p, const f32x4 a, const f32x4 b) {
    u32x4 w; w.x = pk2(a[0], a[1]); w.y = pk2(a[2], a[3]); w.z = pk2(b[0], b[1]); w.w = pk2(b[2], b[3]); *(u32x4*)p = w;
}
struct FInProj { bf16_t *QKV, *RKV, *LRAW, *G;
    __device__ __forceinline__ void operator()(int row, int col, f32x4 a, f32x4 b) const {
        if (col < 2048) {
#pragma unroll
            for (int i = 0; i < 4; ++i) { a[i] = sigmoidf_(a[i]); b[i] = sigmoidf_(b[i]); }
            st8bf(G + (size_t)row * 2048 + col, a, b);
        }
        else if (col < 5120) { const int cr = col - 2048, sec = cr >> 10, hh = (cr >> 6) & 15, d = cr & 63;
            st8bf(RKV + ((size_t)((row >> 13) * 16 + hh) * S + (row & (S - 1))) * 192 + sec * 64 + d, a, b); }
        else if (col < 5376) st8bf(LRAW + (size_t)row * 256 + (col - 5120), a, b);
        else st8bf(QKV + (size_t)row * 2304 + (col - 5376), a, b);
    }
};
__device__ __forceinline__ float lwf(float z) { return -0.60653065971263342f * __builtin_amdgcn_rcpf(1.0f + __expf(-z)); }
struct FBf16 { bf16_t* O; int ldc;
    __device__ __forceinline__ void operator()(int row, int col, f32x4 a, f32x4 b) const { st8bf(O + (size_t)row * ldc + col, a, b); } };
struct FRelu2 { bf16_t* O; int ldc;
    __device__ __forceinline__ void operator()(int row, int col, f32x4 a, f32x4 b) const {
#pragma unroll
        for (int i = 0; i < 4; ++i) { float r = fmaxf(a[i], 0.f); a[i] = r * r; r = fmaxf(b[i], 0.f); b[i] = r * r; }
        st8bf(O + (size_t)row * ldc + col, a, b); } };
struct FM1 { const bf16_t* G; bf16_t* MRG;
    __device__ __forceinline__ void operator()(int row, int col, f32x4 a, f32x4 b) const {
        float g[8]; unpack8(*(const u32x4*)(G + (size_t)row * 2048 + col), g);
        a = (f32x4){a[0] * g[0], a[1] * g[1], a[2] * g[2], a[3] * g[3]}; b = (f32x4){b[0] * g[4], b[1] * g[5], b[2] * g[6], b[3] * g[7]};
        st8bf(MRG + (size_t)row * 1024 + col, a, b); } };
struct FM2 { const bf16_t* G; const bf16_t* MRG; bf16_t* O;
    __device__ __forceinline__ void operator()(int row, int col, f32x4 a, f32x4 b) const {
        float g[8], mr[8]; unpack8(*(const u32x4*)(G + (size_t)row * 2048 + 1024 + col), g); unpack8(*(const u32x4*)(MRG + (size_t)row * 1024 + col), mr);
        a = (f32x4){mr[0] + a[0] * g[0], mr[1] + a[1] * g[1], mr[2] + a[2] * g[2], mr[3] + a[3] * g[3]};
        b = (f32x4){mr[4] + b[0] * g[4], mr[5] + b[1] * g[5], mr[6] + b[2] * g[6], mr[7] + b[3] * g[7]};
        st8bf(O + (size_t)row * 1024 + col, a, b); } };

#define RLX_AGENT __ATOMIC_RELAXED, __HIP_MEMORY_SCOPE_AGENT
template <int NV> struct PanelX {
    unsigned long long* xbuf; unsigned* cnt;
    __device__ __forceinline__ void run(const pg8::Unit& u, LAS unsigned char* lds, int wid, int lane, float (&tot)[4]) const {
        LAS float* P = (LAS float*)lds; volatile LAS unsigned* flag = (volatile LAS unsigned*)(lds + 20480);
        asm volatile("s_waitcnt lgkmcnt(0)" ::: "memory"); __builtin_amdgcn_s_barrier(); asm volatile("" ::: "memory");
        const int row = wid * 32 + (lane & 31);
        if (lane < 32) {
            const f32x4 a = *(const LAS f32x4*)(P + (row * 4 + 0) * 4), b = *(const LAS f32x4*)(P + (row * 4 + 1) * 4), c = *(const LAS f32x4*)(P + (row * 4 + 2) * 4), d = *(const LAS f32x4*)(P + (row * 4 + 3) * 4);
            const f32x4 s = (a + b) + (c + d);
            unsigned long long* slot = xbuf + ((size_t)(u.pm * 256 + row) * 4 + u.pn) * NV;
            __hip_atomic_store(slot, ((unsigned long long)__float_as_uint(s[1]) << 32) | __float_as_uint(s[0]), RLX_AGENT);
            if (NV == 2) __hip_atomic_store(slot + 1, ((unsigned long long)__float_as_uint(s[3]) << 32) | __float_as_uint(s[2]), RLX_AGENT);
        }
        asm volatile("s_waitcnt vmcnt(0)" ::: "memory");
        if (lane == 0) __hip_atomic_fetch_add(cnt + 64 * u.pm, 1u, RLX_AGENT);
        if (wid == 0) {
            unsigned sp = 0u;
            for (;;) { if ((unsigned)__builtin_amdgcn_readfirstlane(__hip_atomic_load(cnt + 64 * u.pm, RLX_AGENT)) >= 32u) break; if (++sp > (1u << 22)) break; __builtin_amdgcn_s_sleep(2); }
            __builtin_amdgcn_fence(__ATOMIC_ACQUIRE, "agent");
            if (lane == 0) flag[0] = 1u;
        }
        asm volatile("s_waitcnt vmcnt(0) lgkmcnt(0)" ::: "memory"); __builtin_amdgcn_s_barrier(); asm volatile("" ::: "memory");
        tot[0] = tot[1] = tot[2] = tot[3] = 0.f;
        if (lane < 32) { const unsigned long long* slot = xbuf + (size_t)(u.pm * 256 + row) * 4 * NV;
#pragma unroll
            for (int t = 0; t < 4; ++t) { const unsigned long long w = __hip_atomic_load(slot + t * NV, RLX_AGENT); tot[0] += __uint_as_float((unsigned)w); tot[1] += __uint_as_float((unsigned)(w >> 32));
                if (NV == 2) { const unsigned long long w2 = __hip_atomic_load(slot + t * NV + 1, RLX_AGENT); tot[2] += __uint_as_float((unsigned)w2); tot[3] += __uint_as_float((unsigned)(w2 >> 32)); } } }
    }
};
struct EpiRow1 {
    static constexpr bool PERM = true, AFTER_DRAIN = true;
    const float* x; float* X1; bf16_t* H2; const float* MOD; const float* gpost; const float* gpre2; PanelX<2> px;
    __device__ __forceinline__ void fused(f32x4 (&acc)[2][2][4][2], const pg8::Unit& u, int wr, int wc, int fr, int fq, LAS unsigned char* lds, int wid, int lane) const {
        const int b = (u.pm * 256) >> 13; const float* gt1 = MOD + b * 6144 + 2048; const float* sh2 = MOD + b * 6144 + 3072; const float* sc2 = MOD + b * 6144 + 4096;
        LAS float* P = (LAS float*)lds; LAS float* Sx = (LAS float*)(lds + 16384);
        const int colb = u.pn * 256 + wc * 32 + 8 * fq;
        f32x4 gg[2][2];
#pragma unroll
        for (int bj = 0; bj < 2; ++bj)
#pragma unroll
            for (int n = 0; n < 2; ++n) gg[bj][n] = *(const f32x4*)(gt1 + colb + bj * 128 + 4 * n) * *(const f32x4*)(gpost + colb + bj * 128 + 4 * n);
#pragma unroll
        for (int ai = 0; ai < 2; ++ai)
#pragma unroll
            for (int m = 0; m < 4; ++m) { const int rl = ai * 128 + wr * 64 + m * 16 + fr; const float* xr = x + (size_t)(u.pm * 256 + rl) * 1024 + colb;
                float pA = 0.f, pB = 0.f, pC = 0.f, pD = 0.f;
#pragma unroll
                for (int bj = 0; bj < 2; ++bj)
#pragma unroll
                    for (int n = 0; n < 2; ++n) { const f32x4 xv = *(const f32x4*)(xr + bj * 128 + 4 * n), mv = acc[ai][bj][m][n], t = gg[bj][n] * mv;
                        pA += (mv[0] * mv[0] + mv[1] * mv[1]) + (mv[2] * mv[2] + mv[3] * mv[3]); pB += (xv[0] * xv[0] + xv[1] * xv[1]) + (xv[2] * xv[2] + xv[3] * xv[3]);
                        pC += (xv[0] * t[0] + xv[1] * t[1]) + (xv[2] * t[2] + xv[3] * t[3]); pD += (t[0] * t[0] + t[1] * t[1]) + (t[2] * t[2] + t[3] * t[3]); }
                pA += __shfl_xor(pA, 16); pA += __shfl_xor(pA, 32); pB += __shfl_xor(pB, 16); pB += __shfl_xor(pB, 32);
                pC += __shfl_xor(pC, 16); pC += __shfl_xor(pC, 32); pD += __shfl_xor(pD, 16); pD += __shfl_xor(pD, 32);
                if (fq == 0) *(LAS f32x4*)(P + (rl * 4 + wc) * 4) = (f32x4){pA, pB, pC, pD};
                asm volatile("" ::: "memory"); }
        float tot[4]; px.run(u, lds, wid, lane, tot);
        if (lane < 32) { const float rs = 1.0f / sqrtf(tot[0] * (1.f / 1024.f) + NORM_EPS); const float ss2 = tot[1] + 2.0f * rs * tot[2] + rs * rs * tot[3];
            const int row = wid * 32 + lane; Sx[row * 2] = rs; Sx[row * 2 + 1] = 1.0f / sqrtf(fmaxf(ss2, 0.f) * (1.f / 1024.f) + NORM_EPS); }
        asm volatile("s_waitcnt lgkmcnt(0)" ::: "memory"); __builtin_amdgcn_s_barrier(); asm volatile("" ::: "memory");
#pragma unroll
        for (int ai = 0; ai < 2; ++ai)
#pragma unroll
            for (int m = 0; m < 4; ++m) { const int rl = ai * 128 + wr * 64 + m * 16 + fr; const size_t off = (size_t)(u.pm * 256 + rl) * 1024 + colb;
                const float rs = Sx[rl * 2], rs2 = Sx[rl * 2 + 1];
#pragma unroll
                for (int bj = 0; bj < 2; ++bj) { f32x4 h[2];
#pragma unroll
                    for (int n = 0; n < 2; ++n) { const int cc = colb + bj * 128 + 4 * n; const f32x4 xv = *(const f32x4*)(x + off + bj * 128 + 4 * n); const f32x4 x1 = xv + gg[bj][n] * acc[ai][bj][m][n] * rs;
                        *(f32x4*)(X1 + off + bj * 128 + 4 * n) = x1; h[n] = x1 * rs2 * *(const f32x4*)(gpre2 + cc) * (*(const f32x4*)(sc2 + cc) + 1.0f) + *(const f32x4*)(sh2 + cc); }
                    st8bf(H2 + off + bj * 128, h[0], h[1]); }
                asm volatile("" ::: "memory"); }
    }
};
struct EpiRow2 {
    static constexpr bool PERM = true, AFTER_DRAIN = true;
    float* X1; const float* MOD; const float* gpost2; PanelX<1> px;
    __device__ __forceinline__ void fused(f32x4 (&acc)[2][2][4][2], const pg8::Unit& u, int wr, int wc, int fr, int fq, LAS unsigned char* lds, int wid, int lane) const {
        const int b = (u.pm * 256) >> 13; const float* gt2 = MOD + b * 6144 + 5120;
        LAS float* P = (LAS float*)lds; LAS float* Sx = (LAS float*)(lds + 16384);
        const int colb = u.pn * 256 + wc * 32 + 8 * fq;
#pragma unroll
        for (int ai = 0; ai < 2; ++ai)
#pragma unroll
            for (int m = 0; m < 4; ++m) { const int rl = ai * 128 + wr * 64 + m * 16 + fr; float pA = 0.f;
#pragma unroll
                for (int bj = 0; bj < 2; ++bj)
#pragma unroll
                    for (int n = 0; n < 2; ++n) { const f32x4 mv = acc[ai][bj][m][n]; pA += (mv[0] * mv[0] + mv[1] * mv[1]) + (mv[2] * mv[2] + mv[3] * mv[3]); }
                pA += __shfl_xor(pA, 16); pA += __shfl_xor(pA, 32);
                if (fq == 0) *(LAS f32x4*)(P + (rl * 4 + wc) * 4) = (f32x4){pA, 0.f, 0.f, 0.f}; }
        float tot[4]; px.run(u, lds, wid, lane, tot);
        if (lane < 32) Sx[wid * 32 + lane] = 1.0f / sqrtf(tot[0] * (1.f / 1024.f) + NORM_EPS);
        asm volatile("s_waitcnt lgkmcnt(0)" ::: "memory"); __builtin_amdgcn_s_barrier(); asm volatile("" ::: "memory");
#pragma unroll
        for (int ai = 0; ai < 2; ++ai)
#pragma unroll
            for (int m = 0; m < 4; ++m) { const int rl = ai * 128 + wr * 64 + m * 16 + fr; const size_t off = (size_t)(u.pm * 256 + rl) * 1024 + colb; const float rs = Sx[rl];
#pragma unroll
                for (int bj = 0; bj < 2; ++bj)
#pragma unroll
                    for (int n = 0; n < 2; ++n) { const int cc = colb + bj * 128 + 4 * n; float* pp = X1 + off + bj * 128 + 4 * n;
                        *(f32x4*)pp = *(const f32x4*)pp + *(const f32x4*)(gt2 + cc) * *(const f32x4*)(gpost2 + cc) * acc[ai][bj][m][n] * rs; }
                asm volatile("" ::: "memory"); }
    }
};
template <class E> __device__ __forceinline__ void run_gemm_fused(LAS unsigned char* lds, const bf16_t* A, int lda, const bf16_t* Bt, int ldb, int N, int K, const E& e) {
    asm volatile("" : "+s"(K));
    pg8::Gemm g{A, Bt, M, N, K, lda, ldb}; pg8::StaticOrder So; So.init(M, N, (int)gridDim.x, (int)blockIdx.x);
    pg8::gemm_phase<E, pg8::StaticOrder, false, true>(lds, g, So, e);
}

template <class F> __device__ __forceinline__ void run_gemm(LAS unsigned char* lds, const bf16_t* A, int lda, const bf16_t* Bt, int ldb, int N, int K, const F& f) {
    asm volatile("" : "+s"(K));
    pg8::Gemm g{A, Bt, M, N, K, lda, ldb}; pg8::StaticOrder So; So.init(M, N, (int)gridDim.x, (int)blockIdx.x);
    pg8::EpiG<F> E{f};
    pg8::gemm_phase<pg8::EpiG<F>, pg8::StaticOrder, true, true>(lds, g, So, E);
}

__device__ __forceinline__ int win_vcol(int pc) { return pc < 2304 ? pc + 5376 : (pc < 5632 ? pc - 256 : pc - 5632); }
template <bool VMAP = false> __device__ __forceinline__ void p0_transpose_item(const float* W, int K, int N, bf16_t* WT, LAS float* scr, int item, int lane) {
    const int nblk = N / 32, kb = item / nblk, nb = item % nblk, k0 = 64 * kb, n0 = 32 * nb, v0 = VMAP ? win_vcol(n0) : n0;
#pragma unroll 8
    for (int i = 0; i < 32; ++i) { const int kk = 2 * i + (lane >> 5); scr[kk * 33 + (lane & 31)] = W[(size_t)(k0 + kk) * N + n0 + (lane & 31)]; }
    asm volatile("s_waitcnt lgkmcnt(0)" ::: "memory");
    const int c = lane & 7;
#pragma unroll
    for (int j = 0; j < 4; ++j) { const int n = (lane >> 3) + 8 * j; const LAS float* s = scr + (8 * c) * 33 + n;
        u32x4 o; o.x = pk2(s[0 * 33], s[1 * 33]); o.y = pk2(s[2 * 33], s[3 * 33]); o.z = pk2(s[4 * 33], s[5 * 33]); o.w = pk2(s[6 * 33], s[7 * 33]);
        *(u32x4*)(WT + (size_t)(v0 + n) * K + k0 + 8 * c) = o; }
    asm volatile("s_waitcnt lgkmcnt(0)" ::: "memory");
}

__device__ __forceinline__ void phase0(CP p, LAS unsigned char* lds) {
    const int tid = fresh_tid(), lane = tid & 63, wave = tid >> 6;
    unsigned char* ws = p->ws;
    const int gw = blockIdx.x * 8 + wave, NGW = gridDim.x * 8;
    {
        LAS float* sc = (LAS float*)lds;
        LAS float* red = (LAS float*)(lds + 8192);
        const float* c = p->in[1]; const float* aw = p->in[3]; const float* ab = p->in[4];
        float* MOD = (float*)(ws + WS_MOD);
        for (int it = blockIdx.x; it < 96; it += gridDim.x) {
            for (int i = tid; i < 2048; i += 512) { const float v = c[i]; sc[i] = v / (1.0f + expf(-v)); }
            __syncthreads();
            const int j = it * 64 + lane; float a0 = 0.f, a1 = 0.f;
#pragma unroll 8
            for (int k = wave * 128; k < wave * 128 + 128; ++k) { const float w = aw[(size_t)k * 6144 + j]; a0 += sc[k] * w; a1 += sc[1024 + k] * w; }
            red[(wave * 2 + 0) * 64 + lane] = a0; red[(wave * 2 + 1) * 64 + lane] = a1;
            __syncthreads();
            if (wave < 2) { float s = ab[j];
#pragma unroll
                for (int w = 0; w < 8; ++w) s += red[(w * 2 + wave) * 64 + lane];
                MOD[wave * 6144 + j] = s; }
            __syncthreads();
        }
    }
    {
        const int* pos = (const int*)p->in[2]; float* R = (float*)(ws + WS_ROPE);
        const float inv[8] = {1.0f, 0.19392274474868576f, 0.03760603093086393f, 0.007292664737217109f, 0.001414213562373095f, 0.0002742481756762073f, 5.318295896944988e-05f, 1.031338537721246e-05f};
        if (blockIdx.x >= 96) for (int m = ((int)blockIdx.x - 96) * 512 + tid; m < M; m += ((int)gridDim.x - 96) * 512) { const float pf = (float)pos[m];
#pragma unroll
            for (int i = 0; i < 8; ++i) { float sn, cs; sincosf(pf * inv[i], &sn, &cs); R[(size_t)m * 16 + i] = cs; R[(size_t)m * 16 + 8 + i] = sn; } }
    }
    {
        bf16_t* WL1 = (bf16_t*)(ws + WS_WL1); bf16_t* WL2 = (bf16_t*)(ws + WS_WL2);
        const float* w2 = p->in[12]; const float* a2 = p->in[14]; const float* g2 = p->in[15];
        if (blockIdx.x >= 96) for (int i = ((int)blockIdx.x - 96) * 512 + tid; i < 2048 * 128; i += ((int)gridDim.x - 96) * 512) { const int n = i >> 7, k = i & 127; float v = 0.f;
            if (n < 1024) { if (k < 64) v = w2[k * 1024 + n]; } else { if (k >= 64) v = a2[(k - 64) * 1024 + (n - 1024)]; }
            WL1[i] = (bf16_t)f2bf(v); }
        if (blockIdx.x >= 96) for (int i = ((int)blockIdx.x - 96) * 512 + tid; i < 1024 * 128; i += ((int)gridDim.x - 96) * 512) { const int n = i >> 7, k = i & 127; WL2[i] = (bf16_t)f2bf(g2[k * 1024 + n]); }
    }
}
__device__ __forceinline__ void phase_wt(CP p, LAS unsigned char* lds, int part, int blk0) {
    const int tid = fresh_tid(), lane = tid & 63, wave = tid >> 6;
    unsigned char* ws = p->ws;
    const int gw = ((int)blockIdx.x - blk0) * 8 + wave, NGW = ((int)gridDim.x - blk0) * 8;
    LAS float* scr = (LAS float*)(lds + 16384 + wave * 8704);
    constexpr int I_IN = (1024 / 64) * (NIN / 32), I_F1 = (1024 / 64) * (4096 / 32), I_F2 = (4096 / 64) * (1024 / 32), I_BR = (1280 / 64) * (1024 / 32), I_OUT = (1024 / 64) * (1024 / 32);
    if (part == 0) { for (int it = gw; it < I_IN; it += NGW) p0_transpose_item<true>(p->in[9], 1024, NIN, (bf16_t*)(ws + WS_WIN), scr, it, lane); }
    else {
        constexpr int NIT = I_F1 + I_F2 + I_BR + I_OUT;
        for (int it = gw; it < NIT; it += NGW) {
            int r = it;
            if (r < I_F1) { p0_transpose_item(p->in[23], 1024, 4096, (bf16_t*)(ws + WS_WFF1), scr, r, lane); continue; } r -= I_F1;
            if (r < I_F2) { p0_transpose_item(p->in[24], 4096, 1024, (bf16_t*)(ws + WS_WFF2), scr, r, lane); continue; } r -= I_F2;
            if (r < I_BR) { p0_transpose_item(p->in[21], 1280, 1024, (bf16_t*)(ws + WS_WBR), scr, r, lane); continue; } r -= I_BR;
            p0_transpose_item(p->in[22], 1024, 1024, (bf16_t*)(ws + WS_WOUT), scr, r, lane);
        }
    }
}

__device__ __forceinline__ void phase_h(CP p) {
    const int tid_ = fresh_tid(), lane = tid_ & 63, wave = tid_ >> 6;
    const float* x = p->in[0]; const float* gpre = p->in[5]; const float* MOD = (const float*)(p->ws + WS_MOD); bf16_t* H = (bf16_t*)(p->ws + WS_H);
    const int gw = blockIdx.x * 8 + wave, NGW = gridDim.x * 8;
    for (int m0 = gw; m0 < M; m0 += 4 * NGW) {
        f32x4 v[4][4];
#pragma unroll
        for (int r = 0; r < 4; ++r) { const f32x4* xr = (const f32x4*)(x + (size_t)(m0 + r * NGW) * D) + lane;
#pragma unroll
            for (int j = 0; j < 4; ++j) v[r][j] = xr[64 * j]; }
        const int b = m0 >> 13; const float* sh = MOD + b * 6144; const float* sc = sh + 1024;
        f32x4 gg[4], bsh[4];
#pragma unroll
        for (int j = 0; j < 4; ++j) { const int c = 4 * lane + 256 * j; gg[j] = *(const f32x4*)(gpre + c) * (*(const f32x4*)(sc + c) + 1.0f); bsh[j] = *(const f32x4*)(sh + c); }
#pragma unroll
        for (int r = 0; r < 4; ++r) { float s = 0.f;
#pragma unroll
            for (int j = 0; j < 4; ++j) s += (v[r][j].x * v[r][j].x + v[r][j].y * v[r][j].y) + (v[r][j].z * v[r][j].z + v[r][j].w * v[r][j].w);
            const float rs = 1.0f / sqrtf(wave_sum(s) * (1.f / D) + NORM_EPS);
            u32x2* o8 = (u32x2*)(H + (size_t)(m0 + r * NGW) * D) + lane;
#pragma unroll
            for (int j = 0; j < 4; ++j) { const f32x4 h = v[r][j] * rs * gg[j] + bsh[j]; u32x2 w; w.x = pk2(h.x, h.y); w.y = pk2(h.z, h.w); o8[64 * j] = w; } }
    }
}

__device__ __forceinline__ bf16x8 load_rope(const bf16_t* hp, const float* rp, int q4) {
    if (q4 >= 2) return *(const bf16x8*)(hp + q4 * 8);
    float lo[8], hi[8]; unpack8(*(const u32x4*)hp, lo); unpack8(*(const u32x4*)(hp + 8), hi);
    float cs[8], sn[8]; *(f32x4*)cs = *(const f32x4*)rp; *(f32x4*)(cs + 4) = *(const f32x4*)(rp + 4); *(f32x4*)sn = *(const f32x4*)(rp + 8); *(f32x4*)(sn + 4) = *(const f32x4*)(rp + 12);
    float o[8];
#pragma unroll
    for (int e = 0; e < 8; ++e) o[e] = (q4 == 0) ? (lo[e] * cs[e] - hi[e] * sn[e]) : (lo[e] * sn[e] + hi[e] * cs[e]);
    const u32x4 w = pack8(o); return __builtin_bit_cast(bf16x8, w);
}

typedef short v4i16a_t __attribute__((ext_vector_type(4)));
struct AttnRegs { u32x4 k[4], v[4]; f32x4 rp[4]; };
__device__ __forceinline__ void attn_decode(int it, int& b, int& head, int& dil, int& r, int& n) {
    b = it / 768; const int rem = it % 768; head = rem >> 6; const int blk = rem & 63, g = head >> 2, dsh = 2 * g, nbr = 64 >> dsh; dil = 1 << dsh; r = blk / nbr; n = blk % nbr;
}
__device__ __forceinline__ void attn_issue(CP p, AttnRegs& R, int it) {
    int b, head, dil, r, n; attn_decode(it, b, head, dil, r, n);
    const int tid = fresh_tid(), j = tid >> 1, half = tid & 1, ik = (n - 1) * 128 + j;
    const bf16_t* QKV = (const bf16_t*)(p->ws + WS_QKV); const float* ROPE = (const float*)(p->ws + WS_ROPE);
    const u32x4 z = (u32x4){0u, 0u, 0u, 0u};
    if (ik >= 0) { const int t = ik * dil + r; const bf16_t* src = QKV + ((size_t)b * S + t) * 2304 + head * 64 + half * 32;
#pragma unroll
        for (int i = 0; i < 4; ++i) { R.k[i] = *(const u32x4*)(src + 768 + i * 8); R.v[i] = *(const u32x4*)(src + 1536 + i * 8); }
        if (half == 0) { const float* rp = ROPE + ((size_t)b * S + t) * 16;
#pragma unroll
            for (int i = 0; i < 4; ++i) R.rp[i] = *(const f32x4*)(rp + 4 * i); }
    } else {
#pragma unroll
        for (int i = 0; i < 4; ++i) { R.k[i] = z; R.v[i] = z; R.rp[i] = (f32x4){1.f, 1.f, 1.f, 1.f}; } }
}
__device__ __forceinline__ void attn_commit(AttnRegs& R, LAS bf16_t* Ks, LAS bf16_t* Vs) {
    constexpr int ALD = 72; const int tid = fresh_tid(), j = tid >> 1, half = tid & 1;
    if (half == 0) { float lo[8], hi[8], cs[8], sn[8], o1[8], o2[8]; unpack8(R.k[0], lo); unpack8(R.k[1], hi);
        *(f32x4*)cs = R.rp[0]; *(f32x4*)(cs + 4) = R.rp[1]; *(f32x4*)sn = R.rp[2]; *(f32x4*)(sn + 4) = R.rp[3];
#pragma unroll
        for (int e = 0; e < 8; ++e) { o1[e] = lo[e] * cs[e] - hi[e] * sn[e]; o2[e] = lo[e] * sn[e] + hi[e] * cs[e]; }
        R.k[0] = pack8(o1); R.k[1] = pack8(o2); }
#pragma unroll
    for (int i = 0; i < 4; ++i) { *(LAS u32x4*)(Ks + j * ALD + half * 32 + i * 8) = R.k[i]; *(LAS u32x4*)(Vs + j * ALD + half * 32 + i * 8) = R.v[i]; }
}
__device__ __forceinline__ void phase_attn(CP p, LAS unsigned char* lds) {
    const int tid = fresh_tid(), lane = tid & 63, wv = tid >> 6, ql = lane & 15, q4 = lane >> 4;
    constexpr int ALD = 72;
    LAS bf16_t* Ks = (LAS bf16_t*)lds; LAS bf16_t* Vs = Ks + 256 * ALD;
    const bf16_t* QKV = (const bf16_t*)(p->ws + WS_QKV); const float* ROPE = (const float*)(p->ws + WS_ROPE);
    bf16_t* O = (bf16_t*)(p->ws + WS_O); float* LSE = (float*)(p->ws + WS_LSE);
    AttnRegs R;
    if ((int)blockIdx.x < 1536) { attn_issue(p, R, blockIdx.x); attn_commit(R, Ks, Vs); }
    __syncthreads();
    for (int it = blockIdx.x; it < 1536; it += gridDim.x) {
        int b, head, dil, r, n; attn_decode(it, b, head, dil, r, n);
        const bool more = it + (int)gridDim.x < 1536;
        if (more) attn_issue(p, R, it + gridDim.x);
        const bf16_t* base = QKV + (size_t)b * S * 2304;
        const int q0 = wv * 16, kt0 = wv < 6 ? wv : 6;
        const int tq = (n * 128 + q0 + ql) * dil + r; const size_t mq = (size_t)b * S + tq;
        const bf16_t* qp = base + (size_t)tq * 2304 + head * 64;
        const bf16x8 qf0 = load_rope(qp, ROPE + mq * 16, q4), qf1 = *(const bf16x8*)(qp + 32 + q4 * 8);
        f32x4 sc[10];
#pragma unroll
        for (int i = 0; i < 10; ++i) { const LAS bf16_t* kp = Ks + ((kt0 + i) * 16 + ql) * ALD + q4 * 8;
            const bf16x8 kf0 = *(const LAS bf16x8*)kp, kf1 = *(const LAS bf16x8*)(kp + 32);
            f32x4 a = (f32x4){0.f, 0.f, 0.f, 0.f};
            a = __builtin_amdgcn_mfma_f32_16x16x32_bf16(kf0, qf0, a, 0, 0, 0); a = __builtin_amdgcn_mfma_f32_16x16x32_bf16(kf1, qf1, a, 0, 0, 0); sc[i] = a; }
        const int qq = q0 + ql; float mx = -1e30f;
#pragma unroll
        for (int i = 0; i < 10; ++i)
#pragma unroll
            for (int jj = 0; jj < 4; ++jj) { const int j = (kt0 + i) * 16 + q4 * 4 + jj, lag = qq + 128 - j; const bool ok = (lag >= 0) && (lag <= 128) && ((n - 1) * 128 + j >= 0);
                const float s = ok ? sc[i][jj] * 0.125f : -1e30f; sc[i][jj] = s; mx = fmaxf(mx, s); }
        mx = fmaxf(mx, __shfl_xor(mx, 16)); mx = fmaxf(mx, __shfl_xor(mx, 32));
        float l = 0.f;
#pragma unroll
        for (int i = 0; i < 10; ++i)
#pragma unroll
            for (int jj = 0; jj < 4; ++jj) { const float s = sc[i][jj]; const float e = (s > -1e29f) ? __expf(s - mx) : 0.f; sc[i][jj] = e; l += e; }
        l += __shfl_xor(l, 16); l += __shfl_xor(l, 32);
        const float rl = 1.0f / l;
        bf16x8 pb[5];
#pragma unroll
        for (int s2 = 0; s2 < 5; ++s2) { u32x4 w; w.x = pk2(sc[2 * s2][0], sc[2 * s2][1]); w.y = pk2(sc[2 * s2][2], sc[2 * s2][3]); w.z = pk2(sc[2 * s2 + 1][0], sc[2 * s2 + 1][1]); w.w = pk2(sc[2 * s2 + 1][2], sc[2 * s2 + 1][3]); pb[s2] = __builtin_bit_cast(bf16x8, w); }
        bf16_t* op = O + mq * 768 + head * 64 + q4 * 4;
#pragma unroll
        for (int dt = 0; dt < 4; ++dt) { f32x4 a = (f32x4){0.f, 0.f, 0.f, 0.f};
#pragma unroll
            for (int s2 = 0; s2 < 5; ++s2) {
                const LAS bf16_t* vp = Vs + ((kt0 + 2 * s2) * 16 + q4 * 4 + (ql >> 2)) * ALD + dt * 16 + (ql & 3) * 4;
                const v4i16a_t v0 = __builtin_amdgcn_ds_read_tr16_b64_v4i16((LAS v4i16a_t*)vp), v1 = __builtin_amdgcn_ds_read_tr16_b64_v4i16((LAS v4i16a_t*)(vp + 16 * ALD));
                const bf16x8 vf = (bf16x8){v0[0], v0[1], v0[2], v0[3], v1[0], v1[1], v1[2], v1[3]};
                a = __builtin_amdgcn_mfma_f32_16x16x32_bf16(vf, pb[s2], a, 0, 0, 0); }
            u32x2 w; w.x = pk2(a[0] * rl, a[1] * rl); w.y = pk2(a[2] * rl, a[3] * rl); *(u32x2*)(op + dt * 16) = w; }
        if (q4 == 0) LSE[mq * 12 + head] = mx + __logf(l);
        __syncthreads();
        if (more) attn_commit(R, Ks, Vs);
        __syncthreads();
    }
}

__device__ __forceinline__ void phase_prep(CP p) {
    const bf16_t* LRAW = (const bf16_t*)(p->ws + WS_LRAW); bf16_t* LA = (bf16_t*)(p->ws + WS_LA); const float* mu = p->in[10] + 3072;
    for (int idx = blockIdx.x * 512 + fresh_tid(); idx < M * 32; idx += gridDim.x * 512) {
        const int m = idx >> 5, c8 = (idx & 31) * 8, t = m & (S - 1);
        float cur[8], prv[8], o[8]; unpack8(*(const u32x4*)(LRAW + (size_t)m * 256 + c8), cur);
        if (t > 0) unpack8(*(const u32x4*)(LRAW + (size_t)(m - 1) * 256 + c8), prv); else {
#pragma unroll
            for (int e = 0; e < 8; ++e) prv[e] = 0.f; }
#pragma unroll
        for (int e = 0; e < 8; ++e) { const float u = cur[e] + (prv[e] - cur[e]) * mu[c8 + e]; o[e] = (c8 < 64) ? tanhf(u) : ((c8 < 128) ? u : sigmoidf_(u)); }
        *(u32x4*)(LA + (size_t)m * 256 + c8) = pack8(o);
    }
}

__device__ __forceinline__ void phase_combine(CP p, int blk0) {
    const bf16_t* O = (const bf16_t*)(p->ws + WS_O); const float* LSE = (const float*)(p->ws + WS_LSE); bf16_t* OATT = (bf16_t*)(p->ws + WS_OATT);
    for (int idx = ((int)blockIdx.x - blk0) * 512 + fresh_tid(); idx < M * 32; idx += ((int)gridDim.x - blk0) * 512) {
        const int m = idx >> 5, hh = (idx & 31) >> 3, d8 = (idx & 7) * 8;
        const float l0 = LSE[(size_t)m * 12 + hh], l1 = LSE[(size_t)m * 12 + 4 + hh], l2 = LSE[(size_t)m * 12 + 8 + hh];
        const float mx = fmaxf(l0, fmaxf(l1, l2)); float e0 = __expf(l0 - mx), e1 = __expf(l1 - mx), e2 = __expf(l2 - mx); const float inv = 1.0f / (e0 + e1 + e2); e0 *= inv; e1 *= inv; e2 *= inv;
        float a[8], b[8], c[8], o[8];
        unpack8(*(const u32x4*)(O + (size_t)m * 768 + hh * 64 + d8), a); unpack8(*(const u32x4*)(O + (size_t)m * 768 + (4 + hh) * 64 + d8), b); unpack8(*(const u32x4*)(O + (size_t)m * 768 + (8 + hh) * 64 + d8), c);
#pragma unroll
        for (int e = 0; e < 8; ++e) o[e] = e0 * a[e] + e1 * b[e] + e2 * c[e];
        *(u32x4*)(OATT + (size_t)m * 256 + hh * 64 + d8) = pack8(o);
    }
}


constexpr int LD = 72, MATB = 64 * LD * 2;
constexpr int SC_CUM = 13 * MATB;
constexpr int SC_SEG = SC_CUM + 16384;
constexpr int SC_WC = SC_SEG + 2048;
constexpr int SC_BS = SC_WC + 256;
constexpr int SC_KC = SC_BS + 256;
constexpr int SC_END = SC_KC + 1536;
static_assert(SC_END <= LDS_BYTES, "scan LDS map");
#define SLOT(i) ((LAS bf16_t*)(lds + (i) * MATB))

typedef short v4i16_t __attribute__((ext_vector_type(4)));
__device__ __forceinline__ bf16x8 tr_frag(const LAS bf16_t* base, int l15) {
    const LAS bf16_t* a = base + (l15 >> 2) * LD + (l15 & 3) * 4;
    const v4i16_t lo = __builtin_amdgcn_ds_read_tr16_b64_v4i16((LAS v4i16_t*)a), hi = __builtin_amdgcn_ds_read_tr16_b64_v4i16((LAS v4i16_t*)(a + 4 * LD));
    return (bf16x8){lo[0], lo[1], lo[2], lo[3], hi[0], hi[1], hi[2], hi[3]};
}
template <bool XT, bool NN> __device__ __forceinline__ void mm_block(const LAS bf16_t* X, const LAS bf16_t* Y, int it0, int jt0, int l15, int q4, f32x4 (&acc)[2][2]) {
#pragma unroll
    for (int s = 0; s < 2; ++s) {
        bf16x8 xf[2], yf[2];
#pragma unroll
        for (int a = 0; a < 2; ++a) { if (!XT) xf[a] = *(const LAS bf16x8*)(X + ((it0 + a) * 16 + l15) * LD + s * 32 + q4 * 8); else xf[a] = tr_frag(X + (s * 32 + q4 * 8) * LD + (it0 + a) * 16, l15); }
#pragma unroll
        for (int c = 0; c < 2; ++c) { if (!NN) yf[c] = *(const LAS bf16x8*)(Y + ((jt0 + c) * 16 + l15) * LD + s * 32 + q4 * 8); else yf[c] = tr_frag(Y + (s * 32 + q4 * 8) * LD + (jt0 + c) * 16, l15); }
#pragma unroll
        for (int a = 0; a < 2; ++a)
#pragma unroll
            for (int c = 0; c < 2; ++c) acc[a][c] = __builtin_amdgcn_mfma_f32_16x16x32_bf16(yf[c], xf[a], acc[a][c], 0, 0, 0);
    }
}
template <bool XT, bool NN> __device__ __forceinline__ void mm_row(const LAS bf16_t* X, const LAS bf16_t* Y, int it, int jt0, int l15, int q4, f32x4 (&acc)[2]) {
#pragma unroll
    for (int s = 0; s < 2; ++s) {
        bf16x8 xf, yf[2];
        if (!XT) xf = *(const LAS bf16x8*)(X + (it * 16 + l15) * LD + s * 32 + q4 * 8); else xf = tr_frag(X + (s * 32 + q4 * 8) * LD + it * 16, l15);
#pragma unroll
        for (int c = 0; c < 2; ++c) { if (!NN) yf[c] = *(const LAS bf16x8*)(Y + ((jt0 + c) * 16 + l15) * LD + s * 32 + q4 * 8); else yf[c] = tr_frag(Y + (s * 32 + q4 * 8) * LD + (jt0 + c) * 16, l15); }
#pragma unroll
        for (int c = 0; c < 2; ++c) acc[c] = __builtin_amdgcn_mfma_f32_16x16x32_bf16(yf[c], xf, acc[c], 0, 0, 0);
    }
}
template <bool XT, bool NN> __device__ __forceinline__ void mm_block_1s(const LAS bf16_t* X, const LAS bf16_t* Y, int it0, int jt0, int s, int l15, int q4, f32x4 (&acc)[2][2]) {
    bf16x8 xf[2], yf[2];
#pragma unroll
    for (int a = 0; a < 2; ++a) { if (!XT) xf[a] = *(const LAS bf16x8*)(X + ((it0 + a) * 16 + l15) * LD + s * 32 + q4 * 8); else xf[a] = tr_frag(X + (s * 32 + q4 * 8) * LD + (it0 + a) * 16, l15); }
#pragma unroll
    for (int c = 0; c < 2; ++c) { if (!NN) yf[c] = *(const LAS bf16x8*)(Y + ((jt0 + c) * 16 + l15) * LD + s * 32 + q4 * 8); else yf[c] = tr_frag(Y + (s * 32 + q4 * 8) * LD + (jt0 + c) * 16, l15); }
#pragma unroll
    for (int a = 0; a < 2; ++a)
#pragma unroll
        for (int c = 0; c < 2; ++c) acc[a][c] = __builtin_amdgcn_mfma_f32_16x16x32_bf16(yf[c], xf[a], acc[a][c], 0, 0, 0);
}
template <bool XT, bool NN> __device__ __forceinline__ void mm_row_1s(const LAS bf16_t* X, const LAS bf16_t* Y, int it, int jt0, int s, int l15, int q4, f32x4 (&acc)[2]) {
    bf16x8 xf, yf[2];
    if (!XT) xf = *(const LAS bf16x8*)(X + (it * 16 + l15) * LD + s * 32 + q4 * 8); else xf = tr_frag(X + (s * 32 + q4 * 8) * LD + it * 16, l15);
#pragma unroll
    for (int c = 0; c < 2; ++c) { if (!NN) yf[c] = *(const LAS bf16x8*)(Y + ((jt0 + c) * 16 + l15) * LD + s * 32 + q4 * 8); else yf[c] = tr_frag(Y + (s * 32 + q4 * 8) * LD + (jt0 + c) * 16, l15); }
#pragma unroll
    for (int c = 0; c < 2; ++c) acc[c] = __builtin_amdgcn_mfma_f32_16x16x32_bf16(yf[c], xf, acc[c], 0, 0, 0);
}
#define TRI_MM(XS, YS, INIT, STORE) do { const int role_ = wv & 3; \
    if (role_ == 0 || role_ == 3) { const int it0 = role_ ? 2 : 0, jtb = it0; f32x4 acc[2][2]; FOR_AC { BLK_IJ; acc[a][c] = INIT(i, j0); } \
        mm_block_1s<false, true>(XS, YS, it0, jtb, role_ ? 1 : 0, l15, q4, acc); FOR_AC { BLK_IJ; STORE(i, j0, acc[a][c]); } } \
    else { const int itr_ = role_ - 1; f32x4 acc[2]; _Pragma("unroll") for (int c = 0; c < 2; ++c) { const int i = itr_ * 16 + l15, j0 = (2 + c) * 16 + q4 * 4; acc[c] = INIT(i, j0); } \
        mm_row<false, true>(XS, YS, itr_, 2, l15, q4, acc); _Pragma("unroll") for (int c = 0; c < 2; ++c) { const int i = itr_ * 16 + l15, j0 = (2 + c) * 16 + q4 * 4; STORE(i, j0, acc[c]); } } } while (0)
#define INIT_ZERO(i, j0) ZERO4
#define FOR_AC _Pragma("unroll") for (int a = 0; a < 2; ++a) _Pragma("unroll") for (int c = 0; c < 2; ++c)
#define BLK_IJ const int i = (it0 + a) * 16 + l15, j0 = (jtb + c) * 16 + q4 * 4
__device__ __forceinline__ void st4bf(LAS bf16_t* p, const f32x4 a) { u32x2 w; w.x = pk2(a[0], a[1]); w.y = pk2(a[2], a[3]); *(LAS u32x2*)p = w; }
__device__ __forceinline__ f32x4 ld4bf(const LAS bf16_t* p) { const u32x2 w = *(const LAS u32x2*)p; return (f32x4){bf2f(w.x & 0xffffu), __uint_as_float(w.x & 0xffff0000u), bf2f(w.y & 0xffffu), __uint_as_float(w.y & 0xffff0000u)}; }
#define ZERO4 ((f32x4){0.f, 0.f, 0.f, 0.f})

struct ScanConst { int unused; };
struct ScanLoads { u32x4 xdw, xda, r0, k0, v0, r1, k1, v1; };
__device__ __forceinline__ void scan_issue(CP p, ScanLoads& L, int b, int h, int c) {
    const int tid = fresh_tid(), tt = tid >> 3, c8 = (tid & 7) * 8, ch = h * 64 + c8;
    const bf16_t* RKV = (const bf16_t*)(p->ws + WS_RKV); const bf16_t* LA = (const bf16_t*)(p->ws + WS_LA);
    const size_t m = (size_t)b * S + c * 64 + tt; const bool hasp = (c * 64 + tt) > 0; const u32x4 z = (u32x4){0u, 0u, 0u, 0u};
    L.xdw = *(const u32x4*)(LA + m * 256 + c8); L.xda = *(const u32x4*)(LA + m * 256 + 64 + c8);
    const bf16_t* rk = RKV + ((size_t)(b * 16 + h) * S + c * 64 + tt) * 192 + c8;
    L.r0 = *(const u32x4*)(rk); L.k0 = *(const u32x4*)(rk + 64); L.v0 = *(const u32x4*)(rk + 128);
    L.r1 = hasp ? *(const u32x4*)(rk - 192) : z; L.k1 = hasp ? *(const u32x4*)(rk - 128) : z; L.v1 = hasp ? *(const u32x4*)(rk - 64) : z;
}
__device__ __forceinline__ void scan_consts(CP p, LAS unsigned char* lds, ScanConst& K, int h) {
    const int tid = fresh_tid(), tt = tid >> 3, c8 = (tid & 7) * 8;
    const float* mu = p->in[10]; const float* k_k = p->in[16]; const float* k_a = p->in[17]; const float* r_k = p->in[18]; const bf16_t* WL1 = (const bf16_t*)(p->ws + WS_WL1);
    LAS float* KC = (LAS float*)(lds + SC_KC);
    if (tid < 64) { const int ch = h * 64 + tid; KC[tid] = mu[ch]; KC[64 + tid] = mu[1024 + ch]; KC[128 + tid] = mu[2048 + ch]; KC[192 + tid] = k_k[ch]; KC[256 + tid] = k_a[ch]; KC[320 + tid] = r_k[ch]; }
    *(LAS u32x4*)(SLOT(4) + tt * LD + c8) = *(const u32x4*)(WL1 + (size_t)(h * 64 + tt) * 128 + c8);
    *(LAS u32x4*)(SLOT(5) + tt * LD + c8) = *(const u32x4*)(WL1 + (size_t)(1024 + h * 64 + tt) * 128 + 64 + c8);
    (void)K;
}
__device__ __forceinline__ void scan_stage_x(LAS unsigned char* lds, const ScanLoads& L) { const int tid = fresh_tid(), tt = tid >> 3, c8 = (tid & 7) * 8;
    *(LAS u32x4*)(SLOT(7) + tt * LD + c8) = L.xdw; *(LAS u32x4*)(SLOT(9) + tt * LD + c8) = L.xda; }
__device__ __forceinline__ bf16_t* tm_blob(unsigned char* ws, int item) {
    constexpr int N0 = 2560, N1 = 1194;
    if (item < N0) return (bf16_t*)(ws + WS_WIN) + (size_t)item * 3072;
    if (item < N0 + N1) return (bf16_t*)(ws + 137 * MiB) + (size_t)(item - N0) * 3072;
    return (bf16_t*)(ws + 64 * MiB) + (size_t)(item - N0 - N1) * 3072;
}
__device__ __forceinline__ void tm_piece(int tid, int& blob_off, int& lds_off) {
    if (tid < 256) { const int r = tid >> 3, c = (tid & 7) * 8; blob_off = tid * 8; lds_off = r * LD + c; }
    else { const int t2 = tid - 256, r = 32 + (t2 >> 2), c = 32 + (t2 & 3) * 8; blob_off = 2048 + t2 * 8; lds_off = r * LD + c; }
}
template <int PASS> __device__ __forceinline__ void scan_front(CP p, LAS unsigned char* lds, const ScanConst& K, ScanLoads& L, int b, int h, int cn, int item, u32x2 sc0 = (u32x2){0u, 0u}, u32x2 sc1 = (u32x2){0u, 0u}, u32x4 tmv = (u32x4){0u, 0u, 0u, 0u}) {
    const int tid = fresh_tid(), lane = tid & 63, wv = tid >> 6, l15 = lane & 15, q4 = lane >> 4, it = wv >> 1, jt0 = (wv & 1) * 2;
    const int half = wv >> 2, it0 = ((wv & 3) >> 1) * 2, jtb = (wv & 1) * 2;
    const float* w0 = p->in[11]; const float* a0 = p->in[13];
    LAS float* CUM = (LAS float*)(lds + SC_CUM); LAS float* SEG = (LAS float*)(lds + SC_SEG); LAS float* WCl = (LAS float*)(lds + SC_WC); LAS float* BS = (LAS float*)(lds + SC_BS);
    const int tt = tid >> 3, c8 = (tid & 7) * 8;
    float rc[8], rp[8], kc[8], kp[8], vc[8], vp[8];
    unpack8(L.r0, rc); unpack8(L.k0, kc); unpack8(L.v0, vc); unpack8(L.r1, rp); unpack8(L.k1, kp); unpack8(L.v1, vp);
    { f32x4 acc[2][2] = {{ZERO4, ZERO4}, {ZERO4, ZERO4}};
      if (half == 0) { mm_block<false, false>(SLOT(7), SLOT(4), it0, jtb, l15, q4, acc);
          FOR_AC { BLK_IJ; const f32x4 wb = *(const f32x4*)(w0 + h * 64 + j0); const f32x4 v = acc[a][c];
              *(LAS f32x4*)(CUM + i * 64 + j0) = (f32x4){lwf(wb[0] + v[0]), lwf(wb[1] + v[1]), lwf(wb[2] + v[2]), lwf(wb[3] + v[3])}; } }
      else { mm_block<false, false>(SLOT(9), SLOT(5), it0, jtb, l15, q4, acc);
          FOR_AC { BLK_IJ; const f32x4 ab = *(const f32x4*)(a0 + h * 64 + j0); const f32x4 v = acc[a][c];
              st4bf(SLOT(3) + i * LD + j0, (f32x4){sigmoidf_(ab[0] + v[0]), sigmoidf_(ab[1] + v[1]), sigmoidf_(ab[2] + v[2]), sigmoidf_(ab[3] + v[3])}); } } }
    __syncthreads();
    { const int cc = tid & 63, sg = tid >> 6; float run = 0.f;
#pragma unroll
      for (int e = 0; e < 8; ++e) { run += CUM[(sg * 8 + e) * 64 + cc]; CUM[(sg * 8 + e) * 64 + cc] = run; }
      SEG[sg * 64 + cc] = run; }
    __syncthreads();
    {
        float av[8], cu[8], cpv[8];
        { const f32x4 a_lo = ld4bf(SLOT(3) + tt * LD + c8), a_hi = ld4bf(SLOT(3) + tt * LD + c8 + 4);
          *(f32x4*)av = a_lo; *(f32x4*)(av + 4) = a_hi;
          float off[8];
#pragma unroll
          for (int e = 0; e < 8; ++e) off[e] = 0.f;
          for (int s2 = 0; s2 < wv; ++s2) { const f32x4 o0 = *(const LAS f32x4*)(SEG + s2 * 64 + c8), o1 = *(const LAS f32x4*)(SEG + s2 * 64 + c8 + 4);
#pragma unroll
              for (int e = 0; e < 4; ++e) { off[e] += o0[e]; off[4 + e] += o1[e]; } }
          *(f32x4*)cu = *(const LAS f32x4*)(CUM + tt * 64 + c8); *(f32x4*)(cu + 4) = *(const LAS f32x4*)(CUM + tt * 64 + c8 + 4);
          if (tt & 7) { *(f32x4*)cpv = *(const LAS f32x4*)(CUM + (tt - 1) * 64 + c8); *(f32x4*)(cpv + 4) = *(const LAS f32x4*)(CUM + (tt - 1) * 64 + c8 + 4); }
          else {
#pragma unroll
              for (int e = 0; e < 8; ++e) cpv[e] = 0.f; }
#pragma unroll
          for (int e = 0; e < 8; ++e) { cu[e] += off[e]; cpv[e] += off[e]; } }
        const LAS float* KC = (const LAS float*)(lds + SC_KC) + c8;
#define KCV(a, e) KC[(a) * 64 + (e)]
        float rr[8], ks[8], vs[8], kk[8], ss = 0.f;
#pragma unroll
        for (int e = 0; e < 8; ++e) { rr[e] = rc[e] + (rp[e] - rc[e]) * KCV(0, e); ks[e] = kc[e] + (kp[e] - kc[e]) * KCV(1, e); vs[e] = vc[e] + (vp[e] - vc[e]) * KCV(2, e);
            kk[e] = ks[e] * KCV(3, e); ss += kk[e] * kk[e]; }
        ss = red8(ss); const float rn = 1.0f / fmaxf(sqrtf(ss), 1e-12f);
        float o_a[8], o_b[8], o_k[8], o_r[8], bsum = 0.f;
#pragma unroll
        for (int e = 0; e < 8; ++e) { const float kn = kk[e] * rn, km = ks[e] * (1.0f + (av[e] - 1.0f) * KCV(4, e));
            const float wi = __expf(cu[e]), we = __expf(cpv[e]), rwi = __expf(-cu[e]);
            o_a[e] = -kn * we; o_b[e] = kn * av[e] * rwi; o_k[e] = km * rwi; o_r[e] = rr[e] * wi; bsum += rr[e] * km * KCV(5, e);
            if (tt == 63) WCl[c8 + e] = wi; }
        *(LAS u32x4*)(SLOT(0) + tt * LD + c8) = pack8(o_a); *(LAS u32x4*)(SLOT(1) + tt * LD + c8) = pack8(o_b); *(LAS u32x4*)(SLOT(2) + tt * LD + c8) = pack8(o_k);
        if (PASS == 3) { *(LAS u32x4*)(SLOT(3) + tt * LD + c8) = pack8(o_r); bsum = red8(bsum); if ((tid & 7) == 0) BS[tt] = bsum; }
        *(LAS u32x4*)(SLOT(6) + tt * LD + c8) = pack8(vs);
    }
    if (cn >= 0) scan_issue(p, L, b, h, cn);
    __syncthreads();
    if (PASS == 1) {
    { f32x4 acc[2][2] = {{ZERO4, ZERO4}, {ZERO4, ZERO4}};
      if (half == 0) { mm_block<false, false>(SLOT(1), SLOT(0), it0, jtb, l15, q4, acc);
          FOR_AC { BLK_IJ; f32x4 v = acc[a][c], t0;
#pragma unroll
              for (int e = 0; e < 4; ++e) { v[e] = (i < j0 + e) ? v[e] : 0.f; t0[e] = (i == j0 + e) ? 1.0f : v[e]; }
              st4bf(SLOT(7) + i * LD + j0, v); st4bf(SLOT(10) + i * LD + j0, t0); } }
      else { mm_block<false, false>(SLOT(2), SLOT(0), it0, jtb, l15, q4, acc);
          FOR_AC { BLK_IJ; f32x4 v = acc[a][c];
#pragma unroll
              for (int e = 0; e < 4; ++e) v[e] = (i < j0 + e) ? v[e] : 0.f;
              st4bf(SLOT(12) + i * LD + j0, v); } } }
    __syncthreads();
    if (half == 0) {
#define STORE_N1(i, j0, v) st4bf(SLOT(8) + (i) * LD + (j0), v)
        TRI_MM(SLOT(7), SLOT(7), INIT_ZERO, STORE_N1); }
    __syncthreads();
#define NEU_STEP3(TSRC, TDST, NCUR, NNEXT) do { \
        if (half == 0) { TRI_MM(SLOT(TSRC), SLOT(NCUR), [&](int i_, int j_) { return ld4bf(SLOT(TSRC) + i_ * LD + j_); }, [&](int i_, int j_, f32x4 v_) { st4bf(SLOT(TDST) + i_ * LD + j_, v_); }); } \
        else { TRI_MM(SLOT(NCUR), SLOT(NCUR), INIT_ZERO, [&](int i_, int j_, f32x4 v_) { st4bf(SLOT(NNEXT) + i_ * LD + j_, v_); }); } \
        __syncthreads(); } while (0)
    NEU_STEP3(10, 11, 8, 9);
    NEU_STEP3(11, 10, 9, 8);
    NEU_STEP3(10, 11, 8, 9);
    NEU_STEP3(11, 10, 9, 8);
    if (half == 0) { TRI_MM(SLOT(10), SLOT(8), [&](int i_, int j_) { return ld4bf(SLOT(10) + i_ * LD + j_); }, [&](int i_, int j_, f32x4 v_) { st4bf(SLOT(11) + i_ * LD + j_, v_); }); }
    __syncthreads();
    if (tid < 384) { int bo, lo; tm_piece(tid, bo, lo); *(u32x4*)(tm_blob(p->ws, item) + bo) = *(const LAS u32x4*)(SLOT(11) + lo); }
    } else {
    if (half != 0) { f32x4 acc[2][2] = {{ZERO4, ZERO4}, {ZERO4, ZERO4}}; mm_block<false, false>(SLOT(2), SLOT(0), it0, jtb, l15, q4, acc);
        FOR_AC { BLK_IJ; f32x4 v = acc[a][c];
#pragma unroll
            for (int e = 0; e < 4; ++e) v[e] = (i < j0 + e) ? v[e] : 0.f;
            st4bf(SLOT(12) + i * LD + j0, v); } }
    if (tid < 384) { int bo, lo; tm_piece(tid, bo, lo); *(LAS u32x4*)(SLOT(11) + lo) = tmv; }
    __syncthreads();
    }
    { if (half == 0) { f32x4 acc[2][2] = {{ZERO4, ZERO4}, {ZERO4, ZERO4}};
          if (jtb == 0) mm_block_1s<true, true>(SLOT(0), SLOT(11), it0, jtb, 0, l15, q4, acc); else mm_block<true, true>(SLOT(0), SLOT(11), it0, jtb, l15, q4, acc);
          FOR_AC { BLK_IJ; st4bf(SLOT(7) + i * LD + j0, acc[a][c]); }
          if (PASS == 3) { FOR_AC { acc[a][c] = ZERO4; } mm_block<false, false>(SLOT(1), SLOT(3), it0, jtb, l15, q4, acc);
              FOR_AC { BLK_IJ; f32x4 v = acc[a][c];
#pragma unroll
                  for (int e = 0; e < 4; ++e) v[e] = (i <= j0 + e) ? v[e] : 0.f;
                  st4bf((LAS bf16_t*)(lds + SC_CUM) + i * LD + j0, v); } } }
      else { TRI_MM(SLOT(12), SLOT(11), INIT_ZERO, [&](int i_, int j_, f32x4 v_) { st4bf(SLOT(9) + i_ * LD + j_, v_); });
          if (PASS == 3) { f32x4 acc[2][2] = {{ZERO4, ZERO4}, {ZERO4, ZERO4}}; mm_block<false, false>(SLOT(2), SLOT(3), it0, jtb, l15, q4, acc);
              FOR_AC { BLK_IJ; f32x4 v = acc[a][c];
#pragma unroll
                  for (int e = 0; e < 4; ++e) v[e] = (i <= j0 + e) ? v[e] : 0.f;
                  st4bf(SLOT(8) + i * LD + j0, v); } } } }
    if (PASS == 3) {
        const int vbmt = tid >> 6; *(LAS u32x2*)(SLOT(10) + ((vbmt >> 2) * 16 + (lane & 15)) * LD + (vbmt & 3) * 16 + (lane >> 4) * 4) = sc0;
        const int vbmt1 = vbmt + 8; *(LAS u32x2*)(SLOT(10) + ((vbmt1 >> 2) * 16 + (lane & 15)) * LD + (vbmt1 & 3) * 16 + (lane >> 4) * 4) = sc1; }
    __syncthreads();
}

__device__ __forceinline__ void phase_scanA(CP p, LAS unsigned char* lds) {
    const int tid = fresh_tid(), lane = tid & 63, wv = tid >> 6, l15 = lane & 15, q4 = lane >> 4, it = wv >> 1, jt0 = (wv & 1) * 2;
    bf16_t* G1P = (bf16_t*)(p->ws + WS_G1P); bf16_t* SPP = (bf16_t*)(p->ws + WS_SPP); float* WC = (float*)(p->ws + WS_WC);
    LAS float* WCl = (LAS float*)(lds + SC_WC);
    const int bh = blockIdx.x >> 3, b = bh >> 4, h = bh & 15, cb = blockIdx.x & 7;
    ScanConst K; ScanLoads L;
    scan_consts(p, lds, K, h); scan_issue(p, L, b, h, cb); scan_stage_x(lds, L); __syncthreads();
    for (int i = 0; i < 16; ++i) {
        const int c = cb + 8 * i, item = bh * 128 + c;
        scan_front<1>(p, lds, K, L, b, h, i < 15 ? c + 8 : -1, item);
        if (tid < 64) WC[(size_t)item * 64 + tid] = WCl[tid];
        { const int half = wv >> 2, it0 = ((wv & 3) >> 1) * 2, jtb = (wv & 1) * 2; f32x4 acc[2][2];
          if (half == 0) { FOR_AC { acc[a][c] = ZERO4; } mm_block<true, false>(SLOT(1), SLOT(7), it0, jtb, l15, q4, acc);
              FOR_AC { const int itt = it0 + a, jt = jtb + c; const float wi = WCl[itt * 16 + l15]; const f32x4 v = acc[a][c];
                  u32x2 w; w.x = pk2(v[0] * wi, v[1] * wi); w.y = pk2(v[2] * wi, v[3] * wi);
                  *(u32x2*)(G1P + (size_t)item * 4096 + ((itt * 2 + (jt >> 1)) * 64 + lane) * 8 + (jt & 1) * 4) = w; } }
          else { FOR_AC { BLK_IJ; acc[a][c] = ld4bf(SLOT(2) + i * LD + j0); }
              if (it0 == 2) mm_block_1s<false, true>(SLOT(9), SLOT(1), it0, jtb, 1, l15, q4, acc); else mm_block<false, true>(SLOT(9), SLOT(1), it0, jtb, l15, q4, acc);
              FOR_AC { BLK_IJ; st4bf(SLOT(10) + i * LD + j0, acc[a][c]); } } }
        __syncthreads();
        { f32x4 acc[2] = {ZERO4, ZERO4}; mm_row<true, true>(SLOT(6), SLOT(10), it, jt0, l15, q4, acc);
#pragma unroll
          for (int c = 0; c < 2; ++c) { const int jt = jt0 + c, j0 = jt * 16 + q4 * 4; const f32x4 wc4 = *(const LAS f32x4*)(WCl + j0); const f32x4 v = acc[c];
              u32x2 w; w.x = pk2(v[0] * wc4[0], v[1] * wc4[1]); w.y = pk2(v[2] * wc4[2], v[3] * wc4[3]);
              *(u32x2*)(SPP + (size_t)item * 4096 + ((it * 4 + jt) * 64 + lane) * 4) = w; } }
        if (i < 15) scan_stage_x(lds, L);
        __syncthreads();
    }
}

template <bool DRY> __device__ __forceinline__ void phase_scanB(CP p, LAS unsigned char* lds) {
    if (blockIdx.x >= 32) return;
    const int tid = fresh_tid(), lane = tid & 63, wv = tid >> 6, q4 = lane >> 4;
    const bf16_t* G1P = (const bf16_t*)(p->ws + WS_G1P); bf16_t* SPP = (bf16_t*)(p->ws + WS_SPP); const float* WC = (const float*)(p->ws + WS_WC);
    const int bh = blockIdx.x, vb = wv;
    constexpr int CB = 16640, HB = 4 * CB;
    static_assert(2 * HB <= LDS_BYTES, "pass B LDS");
    u32x4 g[4], s[4]; f32x4 wreg = ZERO4;
#define SB_ISSUE(r) do { _Pragma("unroll") for (int ci = 0; ci < 4; ++ci) { const size_t item = (size_t)bh * 128 + (r) * 4 + ci; g[ci] = *(const u32x4*)(G1P + item * 4096 + tid * 8); s[ci] = *(const u32x4*)(SPP + item * 4096 + tid * 8); } \
        if (tid < 64) wreg = *(const f32x4*)(WC + ((size_t)bh * 128 + (r) * 4 + (tid >> 4)) * 64 + (tid & 15) * 4); } while (0)
#define SB_COMMIT(hf) do { LAS unsigned char* base = lds + (hf) * HB; _Pragma("unroll") for (int ci = 0; ci < 4; ++ci) { *(LAS u32x4*)(base + ci * CB + tid * 16) = g[ci]; *(LAS u32x4*)(base + ci * CB + 8192 + tid * 16) = s[ci]; } \
        if (tid < 64) *(LAS f32x4*)(base + (tid >> 4) * CB + 16384 + (tid & 15) * 16) = wreg; } while (0)
    SB_ISSUE(0); SB_COMMIT(0); __syncthreads();
    f32x4 st[4] = {ZERO4, ZERO4, ZERO4, ZERO4};
    for (int r = 0; r < 32; ++r) {
        if (r + 1 < 32) SB_ISSUE(r + 1);
        if (wv < 4) {
            const LAS unsigned char* base = lds + (r & 1) * HB;
#pragma unroll
            for (int ci = 0; ci < 4; ++ci) { const LAS unsigned char* cbp = base + ci * CB; const size_t item = (size_t)bh * 128 + r * 4 + ci;
                bf16x8 bfr[2];
#pragma unroll
                for (int s2 = 0; s2 < 2; ++s2) { u32x4 o; o.x = pk2(st[2 * s2][0], st[2 * s2][1]); o.y = pk2(st[2 * s2][2], st[2 * s2][3]); o.z = pk2(st[2 * s2 + 1][0], st[2 * s2 + 1][1]); o.w = pk2(st[2 * s2 + 1][2], st[2 * s2 + 1][3]); bfr[s2] = __builtin_bit_cast(bf16x8, o); }
#pragma unroll
                for (int mt = 0; mt < 4; ++mt) { const u32x4 bw = __builtin_bit_cast(u32x4, bfr[mt >> 1]); u32x2 o; o.x = (mt & 1) ? bw.z : bw.x; o.y = (mt & 1) ? bw.w : bw.y;
                    if (!DRY) *(u32x2*)(SPP + item * 4096 + ((vb * 4 + mt) * 64 + lane) * 4) = o; }
#pragma unroll
                for (int mt = 0; mt < 4; ++mt) {
                    const bf16x8 a0 = *(const LAS bf16x8*)(cbp + ((mt * 2 + 0) * 64 + lane) * 16), a1 = *(const LAS bf16x8*)(cbp + ((mt * 2 + 1) * 64 + lane) * 16);
                    const u32x2 sp = *(const LAS u32x2*)(cbp + 8192 + ((vb * 4 + mt) * 64 + lane) * 8); const f32x4 w = *(const LAS f32x4*)(cbp + 16384 + (mt * 16 + q4 * 4) * 4);
                    f32x4 acc = ZERO4;
                    acc = __builtin_amdgcn_mfma_f32_16x16x32_bf16(a0, bfr[0], acc, 0, 0, 0); acc = __builtin_amdgcn_mfma_f32_16x16x32_bf16(a1, bfr[1], acc, 0, 0, 0);
                    const f32x4 spv = (f32x4){bf2f(sp.x & 0xffffu), __uint_as_float(sp.x & 0xffff0000u), bf2f(sp.y & 0xffffu), __uint_as_float(sp.y & 0xffff0000u)};
                    st[mt] = acc + w * st[mt] + spv; }
            }
        }
        if (r + 1 < 32) SB_COMMIT((r + 1) & 1);
        __syncthreads();
    }
    if (DRY && wv < 4) { float* dump = (float*)(p->ws + WS_WC + 2 * MiB) + ((size_t)bh * 4 + vb) * 1024 + lane * 16;
#pragma unroll
        for (int mt = 0; mt < 4; ++mt) *(f32x4*)(dump + mt * 4) = st[mt]; }
#undef SB_ISSUE
#undef SB_COMMIT
}

__device__ __forceinline__ void phase_scanC(CP p, LAS unsigned char* lds) {
    const int tid = fresh_tid(), lane = tid & 63, wv = tid >> 6, l15 = lane & 15, q4 = lane >> 4, it = wv >> 1, jt0 = (wv & 1) * 2;
    const bf16_t* SPP = (const bf16_t*)(p->ws + WS_SPP); const bf16_t* LA = (const bf16_t*)(p->ws + WS_LA); const bf16_t* WL2 = (const bf16_t*)(p->ws + WS_WL2); bf16_t* ORW = (bf16_t*)(p->ws + WS_ORW);
    const float* gn_w = p->in[19]; const float* gn_b = p->in[20];
    LAS float* YT = (LAS float*)(lds + SC_CUM); LAS float* BS = (LAS float*)(lds + SC_BS);
    const int tt = tid >> 3, c8 = (tid & 7) * 8;
    const int bh = blockIdx.x >> 3, b = bh >> 4, h = bh & 15, cb = blockIdx.x & 7, ch = h * 64 + c8;
    ScanConst K; ScanLoads L;
    scan_consts(p, lds, K, h); scan_issue(p, L, b, h, cb); scan_stage_x(lds, L); __syncthreads();
    for (int i = 0; i < 16; ++i) {
        const int c = cb + 8 * i, item = bh * 128 + c;
        const size_t m = (size_t)b * S + c * 64 + tt;
        const u32x2 sc0 = *(const u32x2*)(SPP + (size_t)item * 4096 + (size_t)tid * 4), sc1 = *(const u32x2*)(SPP + (size_t)item * 4096 + (size_t)(tid + 512) * 4);
        u32x4 tmv = (u32x4){0u, 0u, 0u, 0u};
        if (tid < 384) { int bo, lo; tm_piece(tid, bo, lo); tmv = *(const u32x4*)(tm_blob(p->ws, item) + bo); }
        scan_front<3>(p, lds, K, L, b, h, i < 15 ? c + 8 : -1, item, sc0, sc1, tmv);
        const u32x4 xg0 = *(const u32x4*)(LA + m * 256 + 128 + c8), xg1 = *(const u32x4*)(LA + m * 256 + 192 + c8);
        const u32x4 gw0 = *(const u32x4*)(WL2 + (size_t)(h * 64 + tt) * 128 + c8), gw1 = *(const u32x4*)(WL2 + (size_t)(h * 64 + tt) * 128 + 64 + c8);
        const LAS bf16_t* ARBS = (const LAS bf16_t*)(lds + SC_CUM);
        { const int half = wv >> 2, it0 = ((wv & 3) >> 1) * 2, jtb = (wv & 1) * 2; f32x4 acc[2][2];
          if (half == 0) { FOR_AC { BLK_IJ; acc[a][c] = (f32x4){bf2f((unsigned)SLOT(3)[(j0 + 0) * LD + i]), bf2f((unsigned)SLOT(3)[(j0 + 1) * LD + i]), bf2f((unsigned)SLOT(3)[(j0 + 2) * LD + i]), bf2f((unsigned)SLOT(3)[(j0 + 3) * LD + i])}; }
              if (jtb == 0) mm_block_1s<false, true>(SLOT(7), ARBS, it0, jtb, 0, l15, q4, acc); else mm_block<false, true>(SLOT(7), ARBS, it0, jtb, l15, q4, acc);
              FOR_AC { BLK_IJ; st4bf(SLOT(11) + i * LD + j0, acc[a][c]); } }
          else { TRI_MM(SLOT(9), ARBS, [&](int i_, int j_) { return ld4bf(SLOT(8) + i_ * LD + j_); }, [&](int i_, int j_, f32x4 v_) { st4bf(SLOT(12) + i_ * LD + j_, v_); }); } }
        __syncthreads();
        { f32x4 acc[2] = {ZERO4, ZERO4}; mm_row<false, true>(SLOT(10), SLOT(11), it, jt0, l15, q4, acc);
          if (jt0 == 0) mm_row_1s<true, true>(SLOT(6), SLOT(12), it, jt0, 0, l15, q4, acc); else mm_row<true, true>(SLOT(6), SLOT(12), it, jt0, l15, q4, acc);
#pragma unroll
          for (int c = 0; c < 2; ++c) { const int i2 = it * 16 + l15, j0 = (jt0 + c) * 16 + q4 * 4;
#pragma unroll
              for (int e = 0; e < 4; ++e) YT[(j0 + e) * 64 + i2] = acc[c][e]; } }
        *(LAS u32x4*)(SLOT(7) + tt * LD + c8) = xg0; *(LAS u32x4*)(SLOT(8) + tt * LD + c8) = xg1;
        *(LAS u32x4*)(SLOT(0) + tt * LD + c8) = gw0; *(LAS u32x4*)(SLOT(9) + tt * LD + c8) = gw1;
        __syncthreads();
        { f32x4 acc[2] = {ZERO4, ZERO4}; mm_row<false, false>(SLOT(7), SLOT(0), it, jt0, l15, q4, acc); mm_row<false, false>(SLOT(8), SLOT(9), it, jt0, l15, q4, acc);
#pragma unroll
          for (int c = 0; c < 2; ++c) st4bf(SLOT(11) + (it * 16 + l15) * LD + (jt0 + c) * 16 + q4 * 4, acc[c]); }
        __syncthreads();
        {
            float y[8], g[8], vv[8], o[8], gnw[8], gnb[8];
            *(f32x4*)gnw = *(const f32x4*)(gn_w + ch); *(f32x4*)(gnw + 4) = *(const f32x4*)(gn_w + ch + 4); *(f32x4*)gnb = *(const f32x4*)(gn_b + ch); *(f32x4*)(gnb + 4) = *(const f32x4*)(gn_b + ch + 4);
            *(f32x4*)y = *(const LAS f32x4*)(YT + tt * 64 + c8); *(f32x4*)(y + 4) = *(const LAS f32x4*)(YT + tt * 64 + c8 + 4);
            *(f32x4*)g = ld4bf(SLOT(11) + tt * LD + c8); *(f32x4*)(g + 4) = ld4bf(SLOT(11) + tt * LD + c8 + 4);
            unpack8(*(const LAS u32x4*)(SLOT(6) + tt * LD + c8), vv);
            float sm = 0.f;
#pragma unroll
            for (int e = 0; e < 8; ++e) sm += y[e];
            const float mean = red8(sm) * (1.f / 64.f); float sq = 0.f;
#pragma unroll
            for (int e = 0; e < 8; ++e) { y[e] -= mean; sq += y[e] * y[e]; }
            const float rstd = 1.0f / sqrtf(red8(sq) * (1.f / 64.f) + GN_EPS), bs = BS[tt];
#pragma unroll
            for (int e = 0; e < 8; ++e) o[e] = (y[e] * rstd * gnw[e] + gnb[e] + bs * vv[e]) * g[e];
            *(u32x4*)(ORW + m * 1024 + ch) = pack8(o);
        }
        if (i < 15) scan_stage_x(lds, L);
        __syncthreads();
    }
}

__global__ void __launch_bounds__(512, 2) fwd_megakernel(Params p_unused) {
    extern __shared__ __attribute__((aligned(16))) unsigned char lds_raw[];
    LAS unsigned char* lds = (LAS unsigned char*)lds_raw;
    volatile LAS unsigned* bst = (volatile LAS unsigned*)(lds + LDS_BYTES - 16);
    if (threadIdx.x < 4) bst[threadIdx.x] = 0u;
    __syncthreads();
    const XcdBarrier gbar = xcd_barrier_post((unsigned*)(get_params()->ws + WS_CTL), bst);
    phase0(get_params(), lds);
    xcd_barrier(gbar);
    phase_wt(get_params(), lds, 0, 0);
    phase_h(get_params());
    xcd_barrier(gbar);
    {
        CP p = get_params(); unsigned char* ws = p->ws;
        FInProj f{(bf16_t*)(ws + WS_QKV), (bf16_t*)(ws + WS_RKV), (bf16_t*)(ws + WS_LRAW), (bf16_t*)p->out};
        run_gemm(lds, (const bf16_t*)(ws + WS_H), 1024, (const bf16_t*)(ws + WS_WIN), 1024, NIN, 1024, f);
    }
    xcd_barrier(gbar);
    phase_attn(get_params(), lds);
    phase_prep(get_params());
    xcd_barrier(gbar);
    phase_scanA(get_params(), lds);
    xcd_barrier(gbar);
    phase_scanB<false>(get_params(), lds);
    if (blockIdx.x >= 32) { phase_combine(get_params(), 32); phase_wt(get_params(), lds, 1, 32); }
    xcd_barrier(gbar);
    phase_scanC(get_params(), lds);
    xcd_barrier(gbar);
    {
        CP p = get_params(); unsigned char* ws = p->ws;
        FM1 f1{(const bf16_t*)p->out, (bf16_t*)(ws + WS_MRG)};
        run_gemm(lds, (const bf16_t*)(ws + WS_OATT), 256, (const bf16_t*)(ws + WS_WBR), 1280, 1024, 256, f1);
        FM2 f2{(const bf16_t*)p->out, (const bf16_t*)(ws + WS_MRG), (bf16_t*)(ws + WS_MERGED)};
        run_gemm(lds, (const bf16_t*)(ws + WS_ORW), 1024, (const bf16_t*)(ws + WS_WBR) + 256, 1280, 1024, 1024, f2);
    }
    xcd_barrier(gbar);
    {   CP p = get_params(); unsigned char* ws = p->ws;
        EpiRow1 e{p->in[0], p->out, (bf16_t*)(ws + WS_H2), (const float*)(ws + WS_MOD), p->in[6], p->in[7], PanelX<2>{(unsigned long long*)(ws + WS_XB1), (unsigned*)(ws + WS_CTL + 16384)}};
        run_gemm_fused(lds, (const bf16_t*)(ws + WS_MERGED), 1024, (const bf16_t*)(ws + WS_WOUT), 1024, 1024, 1024, e); }
    xcd_barrier(gbar);
    {   unsigned char* ws = get_params()->ws; FRelu2 f{(bf16_t*)(ws + WS_FFH), FF};
        run_gemm(lds, (const bf16_t*)(ws + WS_H2), 1024, (const bf16_t*)(ws + WS_WFF1), 1024, FF, 1024, f); }
    xcd_barrier(gbar);
    {   CP p = get_params(); unsigned char* ws = p->ws;
        EpiRow2 e{p->out, (const float*)(ws + WS_MOD), p->in[8], PanelX<1>{(unsigned long long*)(ws + WS_XB2), (unsigned*)(ws + WS_CTL + 32768)}};
        run_gemm_fused(lds, (const bf16_t*)(ws + WS_FFH), FF, (const bf16_t*)(ws + WS_WFF2), FF, 1024, FF, e); }
}

extern "C" void kernel_launch(void* const* d_in, const int* in_sizes, int n_in, void* d_out, int out_size, void* d_ws, size_t ws_size, hipStream_t stream) {
    static int grid = 0;
    if (grid == 0) {
        if (n_in != 25 || out_size != M * D || ws_size < WS_END) { fprintf(stderr, "kernel_launch: unexpected shapes n_in %d out %d ws %zu\n", n_in, out_size, ws_size); grid = -1; return; }
        int dev = 0, cus = 0, per_cu = 0;
        hipGetDevice(&dev); hipDeviceGetAttribute(&cus, hipDeviceAttributeMultiprocessorCount, dev);
        hipFuncSetAttribute((const void*)fwd_megakernel, hipFuncAttributeMaxDynamicSharedMemorySize, LDS_BYTES);
        hipOccupancyMaxActiveBlocksPerMultiprocessor(&per_cu, (const void*)fwd_megakernel, 512, LDS_BYTES);
        if (per_cu < 1) { fprintf(stderr, "kernel_launch: occupancy query says %d blocks per CU\n", per_cu); per_cu = 1; }
        grid = cus * 1;
        if (grid != 256) { fprintf(stderr, "kernel_launch: this kernel's scan passes are laid out for a 256-CU grid, got %d CUs\n", cus); grid = -1; return; }
        fprintf(stderr, "kernel_launch: cus %d per_cu %d grid %d\n", cus, per_cu, grid);
    }
    if (grid < 0) return;
    Params p{};
    for (int i = 0; i < 25; ++i) p.in[i] = (const float*)d_in[i];
    p.out = (float*)d_out; p.ws = (unsigned char*)d_ws;
    if (hipMemsetAsync((char*)d_ws + WS_CTL, 0, CTL_BYTES, stream) != hipSuccess) { fprintf(stderr, "kernel_launch: memset of the barrier words failed\n"); return; }
    hipLaunchKernelGGL(fwd_megakernel, dim3(grid), dim3(512), LDS_BYTES, stream, p);
    const hipError_t e = hipPeekAtLastError();
    if (e != hipSuccess) fprintf(stderr, "launch failed: %s (grid %d)\n", hipGetErrorString(e), grid);
}
```

```cpp
#include <hip/hip_runtime.h>
#include <cstdio>
#include <cstdint>

namespace pg8 {
#define PG8_LAS __attribute__((address_space(3)))
typedef unsigned short bf16_t;
typedef short bf16x8 __attribute__((ext_vector_type(8)));
typedef float f32x4 __attribute__((ext_vector_type(4)));
typedef unsigned u32x4 __attribute__((ext_vector_type(4)));
constexpr int BM = 256, BK = 64, HALF = 128, HTB = HALF * BK * 2  , STAGE_BYTES = 8 * HTB, NXCD = 8, WGM = 4;

__host__ __device__ __forceinline__ int lds_byte(int r, int c) { const int st = (r >> 4) * 2 + (c >> 5), rr = r & 15, cc = c & 31, ob = rr * 64 + cc * 2; return st * 1024 + (ob ^ (((ob >> 9) & 1) << 5)); }
__host__ __device__ __forceinline__ void stage_rc(int b, int& R, int& C) { const int st = b / 1024, sb = b % 1024, swz = sb ^ (((sb >> 9) & 1) << 5); R = (st >> 1) * 16 + swz / 64; C = (st & 1) * 32 + (swz % 64) / 2; }
__host__ __device__ __forceinline__ int perm32(int rho) { const int n = rho >> 4, i = rho & 15; return 8 * (i >> 2) + 4 * n + (i & 3); }

struct Unit { int pm, pn; };
struct Gemm { const bf16_t* A; const bf16_t* Bt; int M, N, K, lda, ldb; };

struct StaticOrder {
    int nM, nN, nwg, G, c;
    __host__ __device__ void init(int M, int N, int G_, int c_) { nM = M / BM; nN = N / BM; nwg = nM * nN; G = G_; c = c_; }
    __host__ __device__ bool next(int i, Unit& u) const {
        const long L = (long)i * G + c; if (L >= nwg) return false;
        int wgid = (int)L; { const int q = nwg / NXCD, r = nwg % NXCD, xcd = wgid % NXCD, off = wgid / NXCD; wgid = (xcd < r ? xcd * (q + 1) : r * (q + 1) + (xcd - r) * q) + off; }
        const int nig = WGM * nN, gid = wgid / nig, fm = gid * WGM, gsz = (nM - fm) < WGM ? (nM - fm) : WGM;
        u.pm = fm + ((wgid % nig) % gsz); u.pn = (wgid % nig) / gsz; return true;
    }
    __device__ __forceinline__ void a_ready(const Unit&) const {}
    __device__ __forceinline__ void done(const Unit&) const {}
};

template <class F> struct EpiG {
    static constexpr bool PERM = true, AFTER_DRAIN = false;
    F f;
    __device__ __forceinline__ void operator()(const f32x4 (&acc)[2][2][4][2], const Unit& u, int wr, int wc, int fr, int fq) const {
        const int row0 = u.pm * BM + wr * 64 + fr, col0 = u.pn * BM + wc * 32 + 8 * fq;
#pragma unroll
        for (int ai = 0; ai < 2; ++ai)
#pragma unroll
            for (int m = 0; m < 4; ++m)
#pragma unroll
                for (int bj = 0; bj < 2; ++bj) f(row0 + ai * HALF + m * 16, col0 + bj * HALF, acc[ai][bj][m][0], acc[ai][bj][m][1]);
    }
};

template <class Epi, class Sched, bool ALIGN_EPI = false, bool SP2 = false>
__device__ __forceinline__ void gemm_phase(PG8_LAS unsigned char* lds, const Gemm g, const Sched& S, const Epi& E) {
    int tid_ = threadIdx.x; asm volatile("" : "+v"(tid_));
    const int tid = tid_, wid = __builtin_amdgcn_readfirstlane(tid >> 6), lane = tid & 63, wr = wid >> 2, wc = wid & 3, fr = lane & 15, fq = lane >> 4;
    const int K = g.K, nt = K / BK;
    unsigned voffA[2], voffB[2];
#pragma unroll
    for (int i = 0; i < 2; ++i) { int R, C; stage_rc(tid * 16 + i * 8192, R, C); const int Rb = Epi::PERM ? ((R & ~31) + perm32(R & 31)) : R;
        voffA[i] = (unsigned)(R * g.lda + C) * 2u; voffB[i] = (unsigned)(Rb * g.ldb + C) * 2u; }
    const size_t kstep = (size_t)(BK * 2);
    const size_t hstepA = (size_t)HALF * g.lda * 2, hstepB = (size_t)HALF * g.ldb * 2;
    const size_t tstepA = 2 * hstepA, tstepB = 2 * hstepB;
    const unsigned ldsw = (unsigned)wid * 1024u;
    const int aoff = lds_byte(wr * 64 + fr, fq * 8), boff = lds_byte(wc * 32 + fr, fq * 8);
#define PG8_SA(b, h) (((b) * 2 + (h)) * HTB)
#define PG8_SB(b, h) ((4 + (b) * 2 + (h)) * HTB)
#define PG8_STAGE(bufoff, gbase, voff) do { _Pragma("unroll") for (int _i = 0; _i < 2; ++_i) \
        __builtin_amdgcn_global_load_lds((const unsigned*)((const char*)(gbase) + (voff)[_i]), (PG8_LAS unsigned*)(lds + (bufoff) + ldsw + _i * 8192), 16, 0, 0); } while (0)
#define PG8_LDA(dst, b, h) do { _Pragma("unroll") for (int m = 0; m < 4; ++m) _Pragma("unroll") for (int k = 0; k < 2; ++k) dst[m][k] = *(const PG8_LAS bf16x8*)(lds + PG8_SA(b, h) + aoff + m * 2048 + k * 1024); } while (0)
#define PG8_LDB(dst, b, h) do { _Pragma("unroll") for (int n = 0; n < 2; ++n) _Pragma("unroll") for (int k = 0; k < 2; ++k) dst[n][k] = *(const PG8_LAS bf16x8*)(lds + PG8_SB(b, h) + boff + n * 2048 + k * 1024); } while (0)
#define PG8_MMA(ai, bj, At, Bt) do { __builtin_amdgcn_s_setprio(1); _Pragma("unroll") for (int m = 0; m < 4; ++m) _Pragma("unroll") for (int n = 0; n < 2; ++n) _Pragma("unroll") for (int k = 0; k < 2; ++k) \
        acc[ai][bj][m][n] = __builtin_amdgcn_mfma_f32_16x16x32_bf16(Bt[n][k], At[m][k], acc[ai][bj][m][n], 0, 0, 0); __builtin_amdgcn_s_setprio(0); } while (0)
#define PG8_WAIT_V(n) asm volatile("s_waitcnt vmcnt(" #n ")" ::: "memory")
#define PG8_WAIT_L(n) asm volatile("s_waitcnt lgkmcnt(" #n ")" ::: "memory")
#define PG8_BAR __builtin_amdgcn_s_barrier()
#define PG8_SCHED __builtin_amdgcn_sched_barrier(0)
    Unit cur, nxt; int ui = 0;
    if (!S.next(0, cur)) return;
    f32x4 acc[2][2][4][2];
#pragma unroll
    for (int a = 0; a < 2; ++a)
#pragma unroll
        for (int b = 0; b < 2; ++b)
#pragma unroll
            for (int m = 0; m < 4; ++m)
#pragma unroll
                for (int n = 0; n < 2; ++n) acc[a][b][m][n] = (f32x4){0.f, 0.f, 0.f, 0.f};
    bf16x8 At[4][2], B0[2][2], B1[2][2];
    const char* cA = (const char*)g.A + (size_t)cur.pm * tstepA; const char* cB = (const char*)g.Bt + (size_t)cur.pn * tstepB;
    S.a_ready(cur);
    if constexpr (SP2) {
        PG8_STAGE(PG8_SB(0, 0), cB, voffB); PG8_STAGE(PG8_SB(0, 1), cB + hstepB, voffB); PG8_STAGE(PG8_SA(0, 0), cA, voffA); PG8_STAGE(PG8_SA(0, 1), cA + hstepA, voffA);
        if (wr == 1) PG8_BAR;
        PG8_WAIT_V(2); PG8_BAR;
        PG8_STAGE(PG8_SB(1, 0), cB + kstep, voffB); PG8_STAGE(PG8_SA(1, 0), cA + kstep, voffA); PG8_STAGE(PG8_SB(1, 1), cB + hstepB + kstep, voffB);
        PG8_WAIT_V(6); PG8_BAR;
    } else {
        PG8_STAGE(PG8_SB(0, 0), cB, voffB); PG8_STAGE(PG8_SA(0, 0), cA, voffA); PG8_STAGE(PG8_SB(0, 1), cB + hstepB, voffB); PG8_STAGE(PG8_SA(0, 1), cA + hstepA, voffA);
        if (wr == 1) PG8_BAR;
        PG8_WAIT_V(4); PG8_BAR;
        PG8_STAGE(PG8_SB(1, 0), cB + kstep, voffB); PG8_STAGE(PG8_SA(1, 0), cA + kstep, voffA); PG8_STAGE(PG8_SB(1, 1), cB + hstepB + kstep, voffB);
        PG8_WAIT_V(6); PG8_BAR;
    }
    for (;;) {
        const bool has_next = S.next(ui + 1, nxt);
        const char* nA = has_next ? (const char*)g.A + (size_t)nxt.pm * tstepA : cA; const char* nB = has_next ? (const char*)g.Bt + (size_t)nxt.pn * tstepB : cB;
        for (int t = 0; t < nt; t += 2) {
            const bool last = (t == nt - 2);
            const char* a1 = cA + (size_t)(t + 1) * kstep;
            const char* a2 = last ? nA : cA + (size_t)(t + 2) * kstep; const char* b2 = last ? nB : cB + (size_t)(t + 2) * kstep;
            const char* a3 = a2 + kstep; const char* b3 = b2 + kstep;
            if (last && has_next) S.a_ready(nxt);
            if constexpr (SP2) {
            PG8_LDB(B0, 0, 0); PG8_LDB(B1, 0, 1); PG8_SCHED; PG8_LDA(At, 0, 0); PG8_STAGE(PG8_SA(1, 1), a1 + hstepA, voffA);
            PG8_WAIT_V(8); PG8_WAIT_L(0); PG8_BAR; PG8_MMA(0, 0, At, B0); PG8_MMA(0, 1, At, B1); PG8_BAR; PG8_SCHED;
            PG8_LDA(At, 0, 1); PG8_STAGE(PG8_SB(0, 0), b2, voffB); PG8_STAGE(PG8_SB(0, 1), b2 + hstepB, voffB); PG8_STAGE(PG8_SA(0, 0), a2, voffA);
            PG8_WAIT_V(8); PG8_WAIT_L(0); PG8_BAR; PG8_MMA(1, 0, At, B0); PG8_MMA(1, 1, At, B1); PG8_BAR; PG8_SCHED;
            PG8_LDB(B0, 1, 0); PG8_LDB(B1, 1, 1); PG8_SCHED; PG8_LDA(At, 1, 0); PG8_STAGE(PG8_SA(0, 1), a2 + hstepA, voffA);
            PG8_WAIT_V(8); PG8_WAIT_L(0); PG8_BAR; PG8_MMA(0, 0, At, B0); PG8_MMA(0, 1, At, B1); PG8_BAR; PG8_SCHED;
            PG8_LDA(At, 1, 1); PG8_STAGE(PG8_SB(1, 0), b3, voffB); PG8_STAGE(PG8_SB(1, 1), b3 + hstepB, voffB); PG8_STAGE(PG8_SA(1, 0), a3, voffA);
            PG8_WAIT_V(8); PG8_WAIT_L(0); PG8_BAR; PG8_MMA(1, 0, At, B0); PG8_MMA(1, 1, At, B1); PG8_BAR; PG8_SCHED;
            } else {
            PG8_LDB(B0, 0, 0); PG8_SCHED; PG8_LDA(At, 0, 0); PG8_STAGE(PG8_SA(1, 1), a1 + hstepA, voffA);
            PG8_WAIT_L(8); PG8_BAR; PG8_WAIT_L(0); PG8_MMA(0, 0, At, B0); PG8_BAR; PG8_SCHED;
            PG8_LDB(B1, 0, 1); PG8_STAGE(PG8_SB(0, 0), b2, voffB);
            PG8_BAR; PG8_WAIT_L(0); PG8_MMA(0, 1, At, B1); PG8_BAR;
            PG8_LDA(At, 0, 1); PG8_STAGE(PG8_SA(0, 0), a2, voffA);
            PG8_BAR; PG8_WAIT_L(0); PG8_MMA(1, 0, At, B0); PG8_BAR; PG8_SCHED;
            PG8_STAGE(PG8_SB(0, 1), b2 + hstepB, voffB);
            PG8_WAIT_V(6); PG8_BAR; PG8_MMA(1, 1, At, B1); PG8_BAR;
            PG8_LDB(B0, 1, 0); PG8_SCHED; PG8_LDA(At, 1, 0); PG8_STAGE(PG8_SA(0, 1), a2 + hstepA, voffA);
            PG8_WAIT_L(8); PG8_BAR; PG8_WAIT_L(0); PG8_MMA(0, 0, At, B0); PG8_BAR; PG8_SCHED;
            PG8_LDB(B1, 1, 1); PG8_STAGE(PG8_SB(1, 0), b3, voffB);
            PG8_BAR; PG8_WAIT_L(0); PG8_MMA(0, 1, At, B1); PG8_BAR;
            PG8_LDA(At, 1, 1); PG8_STAGE(PG8_SA(1, 0), a3, voffA);
            PG8_BAR; PG8_WAIT_L(0); PG8_MMA(1, 0, At, B0); PG8_BAR; PG8_SCHED;
            PG8_STAGE(PG8_SB(1, 1), b3 + hstepB, voffB);
            PG8_WAIT_V(6); PG8_BAR; PG8_MMA(1, 1, At, B1); PG8_BAR;
            }
        }
        if constexpr (ALIGN_EPI) { if (wr == 0) PG8_BAR; }
        if constexpr (!Epi::AFTER_DRAIN) { E(acc, cur, wr, wc, fr, fq); S.done(cur); }
        if (!has_next) break;
#pragma unroll
        for (int a = 0; a < 2; ++a)
#pragma unroll
            for (int b = 0; b < 2; ++b)
#pragma unroll
                for (int m = 0; m < 4; ++m)
#pragma unroll
                    for (int n = 0; n < 2; ++n) acc[a][b][m][n] = (f32x4){0.f, 0.f, 0.f, 0.f};
        cur = nxt; cA = nA; cB = nB; ++ui;
        if constexpr (ALIGN_EPI) { if (wr == 1) PG8_BAR; }
    }
    PG8_WAIT_V(0);
    if constexpr (!ALIGN_EPI) { if (wr == 0) PG8_BAR; }
    PG8_BAR;
    if constexpr (Epi::AFTER_DRAIN) { E.fused(acc, cur, wr, wc, fr, fq, lds, wid, lane); S.done(cur); }
#undef PG8_SA
#undef PG8_SB
#undef PG8_STAGE
#undef PG8_LDA
#undef PG8_LDB
#undef PG8_MMA
#undef PG8_WAIT_V
#undef PG8_WAIT_L
#undef PG8_BAR
#undef PG8_SCHED
}
}

#define GAS __attribute__((address_space(1)))
#define LAS __attribute__((address_space(3)))
typedef unsigned short bf16_t;
typedef unsigned u32x4 __attribute__((ext_vector_type(4)));
typedef unsigned u32x2 __attribute__((ext_vector_type(2)));
typedef float f32x4 __attribute__((ext_vector_type(4)));
typedef short bf16x8 __attribute__((ext_vector_type(8)));
typedef short s16x4 __attribute__((ext_vector_type(4)));

constexpr int NB = 2, S = 8192, D = 1024, M = NB * S, FF = 4096;
constexpr int NIN = 7680;
constexpr float NORM_EPS = 1e-6f, GN_EPS = 64e-5f;
constexpr size_t MiB = 1u << 20;
constexpr size_t WS_MOD = 0;
constexpr size_t WS_CTL = 512 * 1024, CTL_BYTES = 49152;
constexpr size_t WS_XB1 = 3 * MiB, WS_XB2 = 5 * MiB;
constexpr size_t WS_ROPE = 1 * MiB;
constexpr size_t WS_LSE = 2 * MiB;
constexpr size_t WS_WIN = 3 * MiB;
constexpr size_t WS_WFF1 = 18 * MiB;
constexpr size_t WS_WFF2 = 26 * MiB;
constexpr size_t WS_WBR = 34 * MiB;
constexpr size_t WS_WOUT = 37 * MiB;
constexpr size_t WS_WL1 = 39 * MiB;
constexpr size_t WS_WL2 = 39 * MiB + 512 * 1024;
constexpr size_t WS_H = 40 * MiB;
constexpr size_t WS_QKV = 72 * MiB;
constexpr size_t WS_RKV = 144 * MiB;
constexpr size_t WS_LRAW = 240 * MiB;
constexpr size_t WS_LA = 248 * MiB;
constexpr size_t WS_END = 256 * MiB;
constexpr size_t WS_O = WS_H;
constexpr size_t WS_Y = WS_H;
constexpr size_t WS_LW = WS_QKV;
constexpr size_t WS_AA = WS_QKV + 32 * MiB;
constexpr size_t WS_GG = WS_QKV;
constexpr size_t WS_ORW = 72 * MiB;
constexpr size_t WS_OATT = WS_LRAW;
constexpr size_t WS_MRG = WS_RKV;
constexpr size_t WS_MERGED = WS_RKV + 64 * MiB;
constexpr size_t WS_MIX = WS_H;
constexpr size_t WS_H2 = 176 * MiB;
constexpr size_t WS_FFH = WS_H;
constexpr size_t WS_F = 168 * MiB;
constexpr size_t WS_G1P = 72 * MiB;
constexpr size_t WS_SPP = 104 * MiB;
constexpr size_t WS_WC = 136 * MiB;
constexpr int LDS_BYTES = 147456;

__device__ __forceinline__ float bf2f(unsigned v) { return __uint_as_float(v << 16); }
__device__ __forceinline__ unsigned f2bf(float f) { unsigned u = __float_as_uint(f); return (u + 0x7fffu + ((u >> 16) & 1u)) >> 16; }
typedef float f32x2_t __attribute__((ext_vector_type(2))); typedef __bf16 bf16x2_t __attribute__((ext_vector_type(2)));
__device__ __forceinline__ unsigned pk2(float lo, float hi) { const f32x2_t v = {lo, hi}; const bf16x2_t b = __builtin_convertvector(v, bf16x2_t); return __builtin_bit_cast(unsigned, b); }
__device__ __forceinline__ void unpack8(const u32x4 v, float* f) {
    f[0] = bf2f(v.x & 0xffffu); f[1] = __uint_as_float(v.x & 0xffff0000u); f[2] = bf2f(v.y & 0xffffu); f[3] = __uint_as_float(v.y & 0xffff0000u);
    f[4] = bf2f(v.z & 0xffffu); f[5] = __uint_as_float(v.z & 0xffff0000u); f[6] = bf2f(v.w & 0xffffu); f[7] = __uint_as_float(v.w & 0xffff0000u);
}
__device__ __forceinline__ u32x4 pack8(const float* f) { u32x4 o; o.x = pk2(f[0], f[1]); o.y = pk2(f[2], f[3]); o.z = pk2(f[4], f[5]); o.w = pk2(f[6], f[7]); return o; }
__device__ __forceinline__ float sigmoidf_(float x) { return __builtin_amdgcn_rcpf(1.0f + __expf(-x)); }
template <int CTRL> __device__ __forceinline__ float dppf(float v) { return __uint_as_float((unsigned)__builtin_amdgcn_update_dpp(0, (int)__float_as_uint(v), CTRL, 0xF, 0xF, true)); }
__device__ __forceinline__ float red8(float v) { v += dppf<0xB1>(v); v += dppf<0x4E>(v); v += dppf<0x141>(v); return v; }
__device__ __forceinline__ float red16(float v) { v = red8(v); v += dppf<0x140>(v); return v; }
__device__ __forceinline__ float wave_sum(float v) {
#pragma unroll
    for (int o = 1; o < 64; o <<= 1) v += __shfl_xor(v, o);
    return v;
}

struct Params { const float* in[25]; float* out; unsigned char* ws; };
typedef const Params __attribute__((address_space(4)))* CP;
__device__ __forceinline__ CP get_params() { CP q = (CP)__builtin_amdgcn_kernarg_segment_ptr(); asm volatile("" : "+s"(q)); return q; }
__device__ __forceinline__ int fresh_tid() { int t = threadIdx.x; asm volatile("" : "+v"(t)); return t; }

#define XB_TMO      128
#define XB_XCNT(j)  (256  + 64 * (j))
#define XB_XSUB(j)  (1280 + 64 * (j))
#define XB_XGEN(j)  (2304 + 64 * (j))
#define XB_TOP      3328
#define XB_TOPGEN   3392
#define XCD_BAR_WORDS 3456
#define XB_SPIN_CAP (1u << 18)

__device__ __forceinline__ unsigned xb_ld(unsigned* p)              { return __hip_atomic_load(p, __ATOMIC_RELAXED, __HIP_MEMORY_SCOPE_AGENT); }
__device__ __forceinline__ unsigned xb_add(unsigned* p, unsigned v) { return __hip_atomic_fetch_add(p, v, __ATOMIC_RELAXED, __HIP_MEMORY_SCOPE_AGENT); }
__device__ __forceinline__ unsigned xb_xcc_id() { return (unsigned)__builtin_amdgcn_s_getreg((3 << 11) | 20) & 0xFu; }
#define XB_SPIN(cond, bar) do { unsigned _sp = 0; while (cond) { __builtin_amdgcn_s_sleep(1); \
    if ((++_sp & 255u) == 0u) { if (xb_ld(&(bar)[XB_TMO])) break; if (_sp > XB_SPIN_CAP) { atomicAdd(&(bar)[XB_TMO], 1u); break; } } } } while (0)

struct XcdBarrier {
    unsigned* bar; unsigned x;
    volatile LAS unsigned* st;
};

__device__ __forceinline__ XcdBarrier xcd_barrier_post(unsigned* bar, volatile LAS unsigned* st) {
    XcdBarrier b; b.bar = bar; b.x = xb_xcc_id(); b.st = st;
    if (threadIdx.x == 0) (void)xb_add(&bar[XB_XCNT(b.x)], 1u);
    return b;
}
__device__ __forceinline__ void xcd_barrier_complete(unsigned* bar, unsigned x, unsigned& nloc, unsigned& nx) {
    const unsigned G = gridDim.x * gridDim.y * gridDim.z;
    unsigned sum, cnt, mine, sp = 0u;
    for (;;) {
        sum = 0u; cnt = 0u; mine = 0u;
#pragma unroll
        for (unsigned j = 0; j < 16; ++j) { const unsigned c = xb_ld(&bar[XB_XCNT(j)]); sum += c; cnt += (c > 0u) ? 1u : 0u; mine = (j == x) ? c : mine; }
        if (sum == G) break;
        __builtin_amdgcn_s_sleep(1);
        if ((++sp & 255u) == 0u) { if (xb_ld(&bar[XB_TMO])) break; if (sp > XB_SPIN_CAP) { atomicAdd(&bar[XB_TMO], 1u); break; } }
    }
    nloc = mine > 0u ? mine : 1u; nx = cnt > 0u ? cnt : 1u;
}

__device__ __forceinline__ void xcd_barrier(const XcdBarrier& b) {
    asm volatile("s_waitcnt vmcnt(0)" ::: "memory");
    __syncthreads();
    if (threadIdx.x == 0) {
        unsigned* bar = b.bar;
        __builtin_amdgcn_s_waitcnt(0);
        unsigned nloc = b.st[0], nx = b.st[1];
        if (nloc == 0u) { xcd_barrier_complete(bar, b.x, nloc, nx); b.st[0] = nloc; b.st[1] = nx; }
        const unsigned old = xb_add(&bar[XB_XSUB(b.x)], 1u);
        const unsigned gen = old / nloc;
        if (old + 1u == (gen + 1u) * nloc) {
            __builtin_amdgcn_fence(__ATOMIC_RELEASE, "agent");
            asm volatile("s_waitcnt vmcnt(0)" ::: "memory");
            const unsigned og = xb_add(&bar[XB_TOP], 1u);
            const unsigned tg = og / nx;
            if (og + 1u == (tg + 1u) * nx) xb_add(&bar[XB_TOPGEN], 1u);
            else XB_SPIN(xb_ld(&bar[XB_TOPGEN]) == tg, bar);
            __builtin_amdgcn_fence(__ATOMIC_ACQUIRE, "agent");
            xb_add(&bar[XB_XGEN(b.x)], 1u);
            asm volatile("s_waitcnt vmcnt(0)" ::: "memory");
        } else {
            XB_SPIN(xb_ld(&bar[XB_XGEN(b.x)]) == gen, bar);
            __builtin_amdgcn_fence(__ATOMIC_ACQUIRE, "agent");
            asm volatile("s_waitcnt vmcnt(0)" ::: "memory");
        }
    }
    __syncthreads();
}


__device__ __forceinline__ void st8bf(bf16_t* p, const f32x4 a, const f32x4 b) {
    u32x4 w; w.x = pk2(a[0], a[1]); w.y = pk2(a[2], a[3]); w.z = pk2(b[0], b[1]); w.w = pk2(b[2], b[3]); *(u32x4*)p = w;
}
struct FInProj { bf16_t *QKV, *RKV, *LRAW, *G;
    __device__ __forceinline__ void operator()(int row, int col, f32x4 a, f32x4 b) const {
        if (col < 2048) {
#pragma unroll
            for (int i = 0; i < 4; ++i) { a[i] = sigmoidf_(a[i]); b[i] = sigmoidf_(b[i]); }
            st8bf(G + (size_t)row * 2048 + col, a, b);
        }
        else if (col < 5120) { const int cr = col - 2048, sec = cr >> 10, hh = (cr >> 6) & 15, d = cr & 63;
            st8bf(RKV + ((size_t)((row >> 13) * 16 + hh) * S + (row & (S - 1))) * 192 + sec * 64 + d, a, b); }
        else if (col < 5376) st8bf(LRAW + (size_t)row * 256 + (col - 5120), a, b);
        else st8bf(QKV + (size_t)row * 2304 + (col - 5376), a, b);
    }
};
__device__ __forceinline__ float lwf(float z) { return -0.60653065971263342f * __builtin_amdgcn_rcpf(1.0f + __expf(-z)); }
struct FBf16 { bf16_t* O; int ldc;
    __device__ __forceinline__ void operator()(int row, int col, f32x4 a, f32x4 b) const { st8bf(O + (size_t)row * ldc + col, a, b); } };
struct FRelu2 { bf16_t* O; int ldc;
    __device__ __forceinline__ void operator()(int row, int col, f32x4 a, f32x4 b) const {
#pragma unroll
        for (int i = 0; i < 4; ++i) { float r = fmaxf(a[i], 0.f); a[i] = r * r; r = fmaxf(b[i], 0.f); b[i] = r * r; }
        st8bf(O + (size_t)row * ldc + col, a, b); } };
struct FM1 { const bf16_t* G; bf16_t* MRG;
    __device__ __forceinline__ void operator()(int row, int col, f32x4 a, f32x4 b) const {
        float g[8]; unpack8(*(const u32x4*)(G + (size_t)row * 2048 + col), g);
        a = (f32x4){a[0] * g[0], a[1] * g[1], a[2] * g[2], a[3] * g[3]}; b = (f32x4){b[0] * g[4], b[1] * g[5], b[2] * g[6], b[3] * g[7]};
        st8bf(MRG + (size_t)row * 1024 + col, a, b); } };
struct FM2 { const bf16_t* G; const bf16_t* MRG; bf16_t* O;
    __device__ __forceinline__ void operator()(int row, int col, f32x4 a, f32x4 b) const {
        float g[8], mr[8]; unpack8(*(const u32x4*)(G + (size_t)row * 2048 + 1024 + col), g); unpack8(*(const u32x4*)(MRG + (size_t)row * 1024 + col), mr);
        a = (f32x4){mr[0] + a[0] * g[0], mr[1] + a[1] * g[1], mr[2] + a[2] * g[2], mr[3] + a[3] * g[3]};
        b = (f32x4){mr[4] + b[0] * g[4], mr[5] + b[1] * g[5], mr[6] + b[2] * g[6], mr[7] + b[3] * g[7]};
        st8bf(O + (size_t)row * 1024 + col, a, b); } };

#define RLX_AGENT __ATOMIC_RELAXED, __HIP_MEMORY_SCOPE_AGENT
template <int NV> struct PanelX {
    unsigned long long* xbuf; unsigned* cnt;
    __device__ __forceinline__ void run(const pg8::Unit& u, LAS unsigned char* lds, int wid, int lane, float (&tot)[4]) const {
        LAS float* P = (LAS float*)lds; volatile LAS unsigned* flag = (volatile LAS unsigned*)(lds + 20480);
        asm volatile("s_waitcnt lgkmcnt(0)" ::: "memory"); __builtin_amdgcn_s_barrier(); asm volatile("" ::: "memory");
        const int row = wid * 32 + (lane & 31);
        if (lane < 32) {
            const f32x4 a = *(const LAS f32x4*)(P + (row * 4 + 0) * 4), b = *(const LAS f32x4*)(P + (row * 4 + 1) * 4), c = *(const LAS f32x4*)(P + (row * 4 + 2) * 4), d = *(const LAS f32x4*)(P + (row * 4 + 3) * 4);
            const f32x4 s = (a + b) + (c + d);
            unsigned long long* slot = xbuf + ((size_t)(u.pm * 256 + row) * 4 + u.pn) * NV;
            __hip_atomic_store(slot, ((unsigned long long)__float_as_uint(s[1]) << 32) | __float_as_uint(s[0]), RLX_AGENT);
            if (NV == 2) __hip_atomic_store(slot + 1, ((unsigned long long)__float_as_uint(s[3]) << 32) | __float_as_uint(s[2]), RLX_AGENT);
        }
        asm volatile("s_waitcnt vmcnt(0)" ::: "memory");
        if (lane == 0) __hip_atomic_fetch_add(cnt + 64 * u.pm, 1u, RLX_AGENT);
        if (wid == 0) {
            unsigned sp = 0u;
            for (;;) { if ((unsigned)__builtin_amdgcn_readfirstlane(__hip_atomic_load(cnt + 64 * u.pm, RLX_AGENT)) >= 32u) break; if (++sp > (1u << 22)) break; __builtin_amdgcn_s_sleep(2); }
            __builtin_amdgcn_fence(__ATOMIC_ACQUIRE, "agent");
            if (lane == 0) flag[0] = 1u;
        }
        asm volatile("s_waitcnt vmcnt(0) lgkmcnt(0)" ::: "memory"); __builtin_amdgcn_s_barrier(); asm volatile("" ::: "memory");
        tot[0] = tot[1] = tot[2] = tot[3] = 0.f;
        if (lane < 32) { const unsigned long long* slot = xbuf + (size_t)(u.pm * 256 + row) * 4 * NV;
#pragma unroll
            for (int t = 0; t < 4; ++t) { const unsigned long long w = __hip_atomic_load(slot + t * NV, RLX_AGENT); tot[0] += __uint_as_float((unsigned)w); tot[1] += __uint_as_float((unsigned)(w >> 32));
                if (NV == 2) { const unsigned long long w2 = __hip_atomic_load(slot + t * NV + 1, RLX_AGENT); tot[2] += __uint_as_float((unsigned)w2); tot[3] += __uint_as_float((unsigned)(w2 >> 32)); } } }
    }
};
struct EpiRow1 {
    static constexpr bool PERM = true, AFTER_DRAIN = true;
    const float* x; float* X1; bf16_t* H2; const float* MOD; const float* gpost; const float* gpre2; PanelX<2> px;
    __device__ __forceinline__ void fused(f32x4 (&acc)[2][2][4][2], const pg8::Unit& u, int wr, int wc, int fr, int fq, LAS unsigned char* lds, int wid, int lane) const {
        const int b = (u.pm * 256) >> 13; const float* gt1 = MOD + b * 6144 + 2048; const float* sh2 = MOD + b * 6144 + 3072; const float* sc2 = MOD + b * 6144 + 4096;
        LAS float* P = (LAS float*)lds; LAS float* Sx = (LAS float*)(lds + 16384);
        const int colb = u.pn * 256 + wc * 32 + 8 * fq;
        f32x4 gg[2][2];
#pragma unroll
        for (int bj = 0; bj < 2; ++bj)
#pragma unroll
            for (int n = 0; n < 2; ++n) gg[bj][n] = *(const f32x4*)(gt1 + colb + bj * 128 + 4 * n) * *(const f32x4*)(gpost + colb + bj * 128 + 4 * n);
#pragma unroll
        for (int ai = 0; ai < 2; ++ai)
#pragma unroll
            for (int m = 0; m < 4; ++m) { const int rl = ai * 128 + wr * 64 + m * 16 + fr; const float* xr = x + (size_t)(u.pm * 256 + rl) * 1024 + colb;
                float pA = 0.f, pB = 0.f, pC = 0.f, pD = 0.f;
#pragma unroll
                for (int bj = 0; bj < 2; ++bj)
#pragma unroll
                    for (int n = 0; n < 2; ++n) { const f32x4 xv = *(const f32x4*)(xr + bj * 128 + 4 * n), mv = acc[ai][bj][m][n], t = gg[bj][n] * mv;
                        pA += (mv[0] * mv[0] + mv[1] * mv[1]) + (mv[2] * mv[2] + mv[3] * mv[3]); pB += (xv[0] * xv[0] + xv[1] * xv[1]) + (xv[2] * xv[2] + xv[3] * xv[3]);
                        pC += (xv[0] * t[0] + xv[1] * t[1]) + (xv[2] * t[2] + xv[3] * t[3]); pD += (t[0] * t[0] + t[1] * t[1]) + (t[2] * t[2] + t[3] * t[3]); }
                pA += __shfl_xor(pA, 16); pA += __shfl_xor(pA, 32); pB += __shfl_xor(pB, 16); pB += __shfl_xor(pB, 32);
                pC += __shfl_xor(pC, 16); pC += __shfl_xor(pC, 32); pD += __shfl_xor(pD, 16); pD += __shfl_xor(pD, 32);
                if (fq == 0) *(LAS f32x4*)(P + (rl * 4 + wc) * 4) = (f32x4){pA, pB, pC, pD};
                asm volatile("" ::: "memory"); }
        float tot[4]; px.run(u, lds, wid, lane, tot);
        if (lane < 32) { const float rs = 1.0f / sqrtf(tot[0] * (1.f / 1024.f) + NORM_EPS); const float ss2 = tot[1] + 2.0f * rs * tot[2] + rs * rs * tot[3];
            const int row = wid * 32 + lane; Sx[row * 2] = rs; Sx[row * 2 + 1] = 1.0f / sqrtf(fmaxf(ss2, 0.f) * (1.f / 1024.f) + NORM_EPS); }
        asm volatile("s_waitcnt lgkmcnt(0)" ::: "memory"); __builtin_amdgcn_s_barrier(); asm volatile("" ::: "memory");
#pragma unroll
        for (int ai = 0; ai < 2; ++ai)
#pragma unroll
            for (int m = 0; m < 4; ++m) { const int rl = ai * 128 + wr * 64 + m * 16 + fr; const size_t off = (size_t)(u.pm * 256 + rl) * 1024 + colb;
                const float rs = Sx[rl * 2], rs2 = Sx[rl * 2 + 1];
#pragma unroll
                for (int bj = 0; bj < 2; ++bj) { f32x4 h[2];
#pragma unroll
                    for (int n = 0; n < 2; ++n) { const int cc = colb + bj * 128 + 4 * n; const f32x4 xv = *(const f32x4*)(x + off + bj * 128 + 4 * n); const f32x4 x1 = xv + gg[bj][n] * acc[ai][bj][m][n] * rs;
                        *(f32x4*)(X1 + off + bj * 128 + 4 * n) = x1; h[n] = x1 * rs2 * *(const f32x4*)(gpre2 + cc) * (*(const f32x4*)(sc2 + cc) + 1.0f) + *(const f32x4*)(sh2 + cc); }
                    st8bf(H2 + off + bj * 128, h[0], h[1]); }
                asm volatile("" ::: "memory"); }
    }
};
struct EpiRow2 {
    static constexpr bool PERM = true, AFTER_DRAIN = true;
    float* X1; const float* MOD; const float* gpost2; PanelX<1> px;
    __device__ __forceinline__ void fused(f32x4 (&acc)[2][2][4][2], const pg8::Unit& u, int wr, int wc, int fr, int fq, LAS unsigned char* lds, int wid, int lane) const {
        const int b = (u.pm * 256) >> 13; const float* gt2 = MOD + b * 6144 + 5120;
        LAS float* P = (LAS float*)lds; LAS float* Sx = (LAS float*)(lds + 16384);
        const int colb = u.pn * 256 + wc * 32 + 8 * fq;
#pragma unroll
        for (int ai = 0; ai < 2; ++ai)
#pragma unroll
            for (int m = 0; m < 4; ++m) { const int rl = ai * 128 + wr * 64 + m * 16 + fr; float pA = 0.f;
#pragma unroll
                for (int bj = 0; bj < 2; ++bj)
#pragma unroll
                    for (int n = 0; n < 2; ++n) { const f32x4 mv = acc[ai][bj][m][n]; pA += (mv[0] * mv[0] + mv[1] * mv[1]) + (mv[2] * mv[2] + mv[3] * mv[3]); }
                pA += __shfl_xor(pA, 16); pA += __shfl_xor(pA, 32);
                if (fq == 0) *(LAS f32x4*)(P + (rl * 4 + wc) * 4) = (f32x4){pA, 0.f, 0.f, 0.f}; }
        float tot[4]; px.run(u, lds, wid, lane, tot);
        if (lane < 32) Sx[wid * 32 + lane] = 1.0f / sqrtf(tot[0] * (1.f / 1024.f) + NORM_EPS);
        asm volatile("s_waitcnt lgkmcnt(0)" ::: "memory"); __builtin_amdgcn_s_barrier(); asm volatile("" ::: "memory");
#pragma unroll
        for (int ai = 0; ai < 2; ++ai)
#pragma unroll
            for (int m = 0; m < 4; ++m) { const int rl = ai * 128 + wr * 64 + m * 16 + fr; const size_t off = (size_t)(u.pm * 256 + rl) * 1024 + colb; const float rs = Sx[rl];
#pragma unroll
                for (int bj = 0; bj < 2; ++bj)
#pragma unroll
                    for (int n = 0; n < 2; ++n) { const int cc = colb + bj * 128 + 4 * n; float* pp = X1 + off + bj * 128 + 4 * n;
                        *(f32x4*)pp = *(const f32x4*)pp + *(const f32x4*)(gt2 + cc) * *(const f32x4*)(gpost2 + cc) * acc[ai][bj][m][n] * rs; }
                asm volatile("" ::: "memory"); }
    }
};
template <class E> __device__ __forceinline__ void run_gemm_fused(LAS unsigned char* lds, const bf16_t* A, int lda, const bf16_t* Bt, int ldb, int N, int K, const E& e) {
    asm volatile("" : "+s"(K));
    pg8::Gemm g{A, Bt, M, N, K, lda, ldb}; pg8::StaticOrder So; So.init(M, N, (int)gridDim.x, (int)blockIdx.x);
    pg8::gemm_phase<E, pg8::StaticOrder, false, true>(lds, g, So, e);
}

template <class F> __device__ __forceinline__ void run_gemm(LAS unsigned char* lds, const bf16_t* A, int lda, const bf16_t* Bt, int ldb, int N, int K, const F& f) {
    asm volatile("" : "+s"(K));
    pg8::Gemm g{A, Bt, M, N, K, lda, ldb}; pg8::StaticOrder So; So.init(M, N, (int)gridDim.x, (int)blockIdx.x);
    pg8::EpiG<F> E{f};
    pg8::gemm_phase<pg8::EpiG<F>, pg8::StaticOrder, true, true>(lds, g, So, E);
}

__device__ __forceinline__ int win_vcol(int pc) { return pc < 2304 ? pc + 5376 : (pc < 5632 ? pc - 256 : pc - 5632); }
template <bool VMAP = false> __device__ __forceinline__ void p0_transpose_item(const float* W, int K, int N, bf16_t* WT, LAS float* scr, int item, int lane) {
    const int nblk = N / 32, kb = item / nblk, nb = item % nblk, k0 = 64 * kb, n0 = 32 * nb, v0 = VMAP ? win_vcol(n0) : n0;
#pragma unroll 8
    for (int i = 0; i < 32; ++i) { const int kk = 2 * i + (lane >> 5); scr[kk * 33 + (lane & 31)] = W[(size_t)(k0 + kk) * N + n0 + (lane & 31)]; }
    asm volatile("s_waitcnt lgkmcnt(0)" ::: "memory");
    const int c = lane & 7;
#pragma unroll
    for (int j = 0; j < 4; ++j) { const int n = (lane >> 3) + 8 * j; const LAS float* s = scr + (8 * c) * 33 + n;
        u32x4 o; o.x = pk2(s[0 * 33], s[1 * 33]); o.y = pk2(s[2 * 33], s[3 * 33]); o.z = pk2(s[4 * 33], s[5 * 33]); o.w = pk2(s[6 * 33], s[7 * 33]);
        *(u32x4*)(WT + (size_t)(v0 + n) * K + k0 + 8 * c) = o; }
    asm volatile("s_waitcnt lgkmcnt(0)" ::: "memory");
}

__device__ __forceinline__ void phase0(CP p, LAS unsigned char* lds) {
    const int tid = fresh_tid(), lane = tid & 63, wave = tid >> 6;
    unsigned char* ws = p->ws;
    const int gw = blockIdx.x * 8 + wave, NGW = gridDim.x * 8;
    {
        LAS float* sc = (LAS float*)lds;
        LAS float* red = (LAS float*)(lds + 8192);
        const float* c = p->in[1]; const float* aw = p->in[3]; const float* ab = p->in[4];
        float* MOD = (float*)(ws + WS_MOD);
        for (int it = blockIdx.x; it < 96; it += gridDim.x) {
            for (int i = tid; i < 2048; i += 512) { const float v = c[i]; sc[i] = v / (1.0f + expf(-v)); }
            __syncthreads();
            const int j = it * 64 + lane; float a0 = 0.f, a1 = 0.f;
#pragma unroll 8
            for (int k = wave * 128; k < wave * 128 + 128; ++k) { const float w = aw[(size_t)k * 6144 + j]; a0 += sc[k] * w; a1 += sc[1024 + k] * w; }
            red[(wave * 2 + 0) * 64 + lane] = a0; red[(wave * 2 + 1) * 64 + lane] = a1;
            __syncthreads();
            if (wave < 2) { float s = ab[j];
#pragma unroll
                for (int w = 0; w < 8; ++w) s += red[(w * 2 + wave) * 64 + lane];
                MOD[wave * 6144 + j] = s; }
            __syncthreads();
        }
    }
    {
        const int* pos = (const int*)p->in[2]; float* R = (float*)(ws + WS_ROPE);
        const float inv[8] = {1.0f, 0.19392274474868576f, 0.03760603093086393f, 0.007292664737217109f, 0.001414213562373095f, 0.0002742481756762073f, 5.318295896944988e-05f, 1.031338537721246e-05f};
        if (blockIdx.x >= 96) for (int m = ((int)blockIdx.x - 96) * 512 + tid; m < M; m += ((int)gridDim.x - 96) * 512) { const float pf = (float)pos[m];
#pragma unroll
            for (int i = 0; i < 8; ++i) { float sn, cs; sincosf(pf * inv[i], &sn, &cs); R[(size_t)m * 16 + i] = cs; R[(size_t)m * 16 + 8 + i] = sn; } }
    }
    {
        bf16_t* WL1 = (bf16_t*)(ws + WS_WL1); bf16_t* WL2 = (bf16_t*)(ws + WS_WL2);
        const float* w2 = p->in[12]; const float* a2 = p->in[14]; const float* g2 = p->in[15];
        if (blockIdx.x >= 96) for (int i = ((int)blockIdx.x - 96) * 512 + tid; i < 2048 * 128; i += ((int)gridDim.x - 96) * 512) { const int n = i >> 7, k = i & 127; float v = 0.f;
            if (n < 1024) { if (k < 64) v = w2[k * 1024 + n]; } else { if (k >= 64) v = a2[(k - 64) * 1024 + (n - 1024)]; }
            WL1[i] = (bf16_t)f2bf(v); }
        if (blockIdx.x >= 96) for (int i = ((int)blockIdx.x - 96) * 512 + tid; i < 1024 * 128; i += ((int)gridDim.x - 96) * 512) { const int n = i >> 7, k = i & 127; WL2[i] = (bf16_t)f2bf(g2[k * 1024 + n]); }
    }
}
__device__ __forceinline__ void phase_wt(CP p, LAS unsigned char* lds, int part, int blk0) {
    const int tid = fresh_tid(), lane = tid & 63, wave = tid >> 6;
    unsigned char* ws = p->ws;
    const int gw = ((int)blockIdx.x - blk0) * 8 + wave, NGW = ((int)gridDim.x - blk0) * 8;
    LAS float* scr = (LAS float*)(lds + 16384 + wave * 8704);
    constexpr int I_IN = (1024 / 64) * (NIN / 32), I_F1 = (1024 / 64) * (4096 / 32), I_F2 = (4096 / 64) * (1024 / 32), I_BR = (1280 / 64) * (1024 / 32), I_OUT = (1024 / 64) * (1024 / 32);
    if (part == 0) { for (int it = gw; it < I_IN; it += NGW) p0_transpose_item<true>(p->in[9], 1024, NIN, (bf16_t*)(ws + WS_WIN), scr, it, lane); }
    else {
        constexpr int NIT = I_F1 + I_F2 + I_BR + I_OUT;
        for (int it = gw; it < NIT; it += NGW) {
            int r = it;
            if (r < I_F1) { p0_transpose_item(p->in[23], 1024, 4096, (bf16_t*)(ws + WS_WFF1), scr, r, lane); continue; } r -= I_F1;
            if (r < I_F2) { p0_transpose_item(p->in[24], 4096, 1024, (bf16_t*)(ws + WS_WFF2), scr, r, lane); continue; } r -= I_F2;
            if (r < I_BR) { p0_transpose_item(p->in[21], 1280, 1024, (bf16_t*)(ws + WS_WBR), scr, r, lane); continue; } r -= I_BR;
            p0_transpose_item(p->in[22], 1024, 1024, (bf16_t*)(ws + WS_WOUT), scr, r, lane);
        }
    }
}

__device__ __forceinline__ void phase_h(CP p) {
    const int tid_ = fresh_tid(), lane = tid_ & 63, wave = tid_ >> 6;
    const float* x = p->in[0]; const float* gpre = p->in[5]; const float* MOD = (const float*)(p->ws + WS_MOD); bf16_t* H = (bf16_t*)(p->ws + WS_H);
    for (int m = blockIdx.x * 8 + wave; m < M; m += gridDim.x * 8) {
        const int b = m >> 13; const float* sh = MOD + b * 6144; const float* sc = sh + 1024;
        const f32x4* xr = (const f32x4*)(x + (size_t)m * D) + lane; f32x4 v[4]; float s = 0.f;
#pragma unroll
        for (int j = 0; j < 4; ++j) { v[j] = xr[64 * j]; s += (v[j].x * v[j].x + v[j].y * v[j].y) + (v[j].z * v[j].z + v[j].w * v[j].w); }
        const float rs = 1.0f / sqrtf(wave_sum(s) * (1.f / D) + NORM_EPS);
        u32x2* o8 = (u32x2*)(H + (size_t)m * D) + lane;
#pragma unroll
        for (int j = 0; j < 4; ++j) { const int c = 4 * lane + 256 * j; const f32x4 g = *(const f32x4*)(gpre + c), a = *(const f32x4*)(sc + c), bsh = *(const f32x4*)(sh + c);
            f32x4 h = v[j] * rs * g * (1.0f + a) + bsh; u32x2 w; w.x = pk2(h.x, h.y); w.y = pk2(h.z, h.w); o8[64 * j] = w; }
    }
}

__device__ __forceinline__ bf16x8 load_rope(const bf16_t* hp, const float* rp, int q4) {
    if (q4 >= 2) return *(const bf16x8*)(hp + q4 * 8);
    float lo[8], hi[8]; unpack8(*(const u32x4*)hp, lo); unpack8(*(const u32x4*)(hp + 8), hi);
    float cs[8], sn[8]; *(f32x4*)cs = *(const f32x4*)rp; *(f32x4*)(cs + 4) = *(const f32x4*)(rp + 4); *(f32x4*)sn = *(const f32x4*)(rp + 8); *(f32x4*)(sn + 4) = *(const f32x4*)(rp + 12);
    float o[8];
#pragma unroll
    for (int e = 0; e < 8; ++e) o[e] = (q4 == 0) ? (lo[e] * cs[e] - hi[e] * sn[e]) : (lo[e] * sn[e] + hi[e] * cs[e]);
    const u32x4 w = pack8(o); return __builtin_bit_cast(bf16x8, w);
}

typedef short v4i16a_t __attribute__((ext_vector_type(4)));
struct AttnRegs { u32x4 k[4], v[4]; f32x4 rp[4]; };
__device__ __forceinline__ void attn_decode(int it, int& b, int& head, int& dil, int& r, int& n) {
    b = it / 768; const int rem = it % 768; head = rem >> 6; const int blk = rem & 63, g = head >> 2, dsh = 2 * g, nbr = 64 >> dsh; dil = 1 << dsh; r = blk / nbr; n = blk % nbr;
}
__device__ __forceinline__ void attn_issue(CP p, AttnRegs& R, int it) {
    int b, head, dil, r, n; attn_decode(it, b, head, dil, r, n);
    const int tid = fresh_tid(), j = tid >> 1, half = tid & 1, ik = (n - 1) * 128 + j;
    const bf16_t* QKV = (const bf16_t*)(p->ws + WS_QKV); const float* ROPE = (const float*)(p->ws + WS_ROPE);
    const u32x4 z = (u32x4){0u, 0u, 0u, 0u};
    if (ik >= 0) { const int t = ik * dil + r; const bf16_t* src = QKV + ((size_t)b * S + t) * 2304 + head * 64 + half * 32;
#pragma unroll
        for (int i = 0; i < 4; ++i) { R.k[i] = *(const u32x4*)(src + 768 + i * 8); R.v[i] = *(const u32x4*)(src + 1536 + i * 8); }
        if (half == 0) { const float* rp = ROPE + ((size_t)b * S + t) * 16;
#pragma unroll
            for (int i = 0; i < 4; ++i) R.rp[i] = *(const f32x4*)(rp + 4 * i); }
    } else {
#pragma unroll
        for (int i = 0; i < 4; ++i) { R.k[i] = z; R.v[i] = z; R.rp[i] = (f32x4){1.f, 1.f, 1.f, 1.f}; } }
}
__device__ __forceinline__ void attn_commit(AttnRegs& R, LAS bf16_t* Ks, LAS bf16_t* Vs) {
    constexpr int ALD = 72; const int tid = fresh_tid(), j = tid >> 1, half = tid & 1;
    if (half == 0) { float lo[8], hi[8], cs[8], sn[8], o1[8], o2[8]; unpack8(R.k[0], lo); unpack8(R.k[1], hi);
        *(f32x4*)cs = R.rp[0]; *(f32x4*)(cs + 4) = R.rp[1]; *(f32x4*)sn = R.rp[2]; *(f32x4*)(sn + 4) = R.rp[3];
#pragma unroll
        for (int e = 0; e < 8; ++e) { o1[e] = lo[e] * cs[e] - hi[e] * sn[e]; o2[e] = lo[e] * sn[e] + hi[e] * cs[e]; }
        R.k[0] = pack8(o1); R.k[1] = pack8(o2); }
#pragma unroll
    for (int i = 0; i < 4; ++i) { *(LAS u32x4*)(Ks + j * ALD + half * 32 + i * 8) = R.k[i]; *(LAS u32x4*)(Vs + j * ALD + half * 32 + i * 8) = R.v[i]; }
}
__device__ __forceinline__ void phase_attn(CP p, LAS unsigned char* lds) {
    const int tid = fresh_tid(), lane = tid & 63, wv = tid >> 6, ql = lane & 15, q4 = lane >> 4;
    constexpr int ALD = 72;
    LAS bf16_t* Ks = (LAS bf16_t*)lds; LAS bf16_t* Vs = Ks + 256 * ALD;
    const bf16_t* QKV = (const bf16_t*)(p->ws + WS_QKV); const float* ROPE = (const float*)(p->ws + WS_ROPE);
    bf16_t* O = (bf16_t*)(p->ws + WS_O); float* LSE = (float*)(p->ws + WS_LSE);
    AttnRegs R;
    if ((int)blockIdx.x < 1536) { attn_issue(p, R, blockIdx.x); attn_commit(R, Ks, Vs); }
    __syncthreads();
    for (int it = blockIdx.x; it < 1536; it += gridDim.x) {
        int b, head, dil, r, n; attn_decode(it, b, head, dil, r, n);
        const bool more = it + (int)gridDim.x < 1536;
        if (more) attn_issue(p, R, it + gridDim.x);
        const bf16_t* base = QKV + (size_t)b * S * 2304;
        const int q0 = wv * 16, kt0 = wv < 6 ? wv : 6;
        const int tq = (n * 128 + q0 + ql) * dil + r; const size_t mq = (size_t)b * S + tq;
        const bf16_t* qp = base + (size_t)tq * 2304 + head * 64;
        const bf16x8 qf0 = load_rope(qp, ROPE + mq * 16, q4), qf1 = *(const bf16x8*)(qp + 32 + q4 * 8);
        f32x4 sc[10];
#pragma unroll
        for (int i = 0; i < 10; ++i) { const LAS bf16_t* kp = Ks + ((kt0 + i) * 16 + ql) * ALD + q4 * 8;
            const bf16x8 kf0 = *(const LAS bf16x8*)kp, kf1 = *(const LAS bf16x8*)(kp + 32);
            f32x4 a = (f32x4){0.f, 0.f, 0.f, 0.f};
            a = __builtin_amdgcn_mfma_f32_16x16x32_bf16(kf0, qf0, a, 0, 0, 0); a = __builtin_amdgcn_mfma_f32_16x16x32_bf16(kf1, qf1, a, 0, 0, 0); sc[i] = a; }
        const int qq = q0 + ql; float mx = -1e30f;
#pragma unroll
        for (int i = 0; i < 10; ++i)
#pragma unroll
            for (int jj = 0; jj < 4; ++jj) { const int j = (kt0 + i) * 16 + q4 * 4 + jj, lag = qq + 128 - j; const bool ok = (lag >= 0) && (lag <= 128) && ((n - 1) * 128 + j >= 0);
                const float s = ok ? sc[i][jj] * 0.125f : -1e30f; sc[i][jj] = s; mx = fmaxf(mx, s); }
        mx = fmaxf(mx, __shfl_xor(mx, 16)); mx = fmaxf(mx, __shfl_xor(mx, 32));
        float l = 0.f;
#pragma unroll
        for (int i = 0; i < 10; ++i)
#pragma unroll
            for (int jj = 0; jj < 4; ++jj) { const float s = sc[i][jj]; const float e = (s > -1e29f) ? __expf(s - mx) : 0.f; sc[i][jj] = e; l += e; }
        l += __shfl_xor(l, 16); l += __shfl_xor(l, 32);
        const float rl = __builtin_amdgcn_rcpf(l);
        bf16x8 pb[5];
#pragma unroll
        for (int s2 = 0; s2 < 5; ++s2) { u32x4 w; w.x = pk2(sc[2 * s2][0], sc[2 * s2][1]); w.y = pk2(sc[2 * s2][2], sc[2 * s2][3]); w.z = pk2(sc[2 * s2 + 1][0], sc[2 * s2 + 1][1]); w.w = pk2(sc[2 * s2 + 1][2], sc[2 * s2 + 1][3]); pb[s2] = __builtin_bit_cast(bf16x8, w); }
        bf16_t* op = O + mq * 768 + head * 64 + q4 * 4;
#pragma unroll
        for (int dt = 0; dt < 4; ++dt) { f32x4 a = (f32x4){0.f, 0.f, 0.f, 0.f};
#pragma unroll
            for (int s2 = 0; s2 < 5; ++s2) {
                const LAS bf16_t* vp = Vs + ((kt0 + 2 * s2) * 16 + q4 * 4 + (ql >> 2)) * ALD + dt * 16 + (ql & 3) * 4;
                const v4i16a_t v0 = __builtin_amdgcn_ds_read_tr16_b64_v4i16((LAS v4i16a_t*)vp), v1 = __builtin_amdgcn_ds_read_tr16_b64_v4i16((LAS v4i16a_t*)(vp + 16 * ALD));
                const bf16x8 vf = (bf16x8){v0[0], v0[1], v0[2], v0[3], v1[0], v1[1], v1[2], v1[3]};
                a = __builtin_amdgcn_mfma_f32_16x16x32_bf16(vf, pb[s2], a, 0, 0, 0); }
            u32x2 w; w.x = pk2(a[0] * rl, a[1] * rl); w.y = pk2(a[2] * rl, a[3] * rl); *(u32x2*)(op + dt * 16) = w; }
        if (q4 == 0) LSE[mq * 12 + head] = mx + __logf(l);
        __syncthreads();
        if (more) attn_commit(R, Ks, Vs);
        __syncthreads();
    }
}

__device__ __forceinline__ void phase_prep(CP p) {
    const bf16_t* LRAW = (const bf16_t*)(p->ws + WS_LRAW); bf16_t* LA = (bf16_t*)(p->ws + WS_LA); const float* mu = p->in[10] + 3072;
    for (int idx = blockIdx.x * 512 + fresh_tid(); idx < M * 32; idx += gridDim.x * 512) {
        const int m = idx >> 5, c8 = (idx & 31) * 8, t = m & (S - 1);
        float cur[8], prv[8], o[8]; unpack8(*(const u32x4*)(LRAW + (size_t)m * 256 + c8), cur);
        if (t > 0) unpack8(*(const u32x4*)(LRAW + (size_t)(m - 1) * 256 + c8), prv); else {
#pragma unroll
            for (int e = 0; e < 8; ++e) prv[e] = 0.f; }
#pragma unroll
        for (int e = 0; e < 8; ++e) { const float u = cur[e] + (prv[e] - cur[e]) * mu[c8 + e]; o[e] = (c8 < 64) ? tanhf(u) : ((c8 < 128) ? u : sigmoidf_(u)); }
        *(u32x4*)(LA + (size_t)m * 256 + c8) = pack8(o);
    }
}

__device__ __forceinline__ void phase_combine(CP p, int blk0) {
    const bf16_t* O = (const bf16_t*)(p->ws + WS_O); const float* LSE = (const float*)(p->ws + WS_LSE); bf16_t* OATT = (bf16_t*)(p->ws + WS_OATT);
    for (int idx = ((int)blockIdx.x - blk0) * 512 + fresh_tid(); idx < M * 32; idx += ((int)gridDim.x - blk0) * 512) {
        const int m = idx >> 5, hh = (idx & 31) >> 3, d8 = (idx & 7) * 8;
        const float l0 = LSE[(size_t)m * 12 + hh], l1 = LSE[(size_t)m * 12 + 4 + hh], l2 = LSE[(size_t)m * 12 + 8 + hh];
        const float mx = fmaxf(l0, fmaxf(l1, l2)); float e0 = __expf(l0 - mx), e1 = __expf(l1 - mx), e2 = __expf(l2 - mx); const float inv = __builtin_amdgcn_rcpf(e0 + e1 + e2); e0 *= inv; e1 *= inv; e2 *= inv;
        float a[8], b[8], c[8], o[8];
        unpack8(*(const u32x4*)(O + (size_t)m * 768 + hh * 64 + d8), a); unpack8(*(const u32x4*)(O + (size_t)m * 768 + (4 + hh) * 64 + d8), b); unpack8(*(const u32x4*)(O + (size_t)m * 768 + (8 + hh) * 64 + d8), c);
#pragma unroll
        for (int e = 0; e < 8; ++e) o[e] = e0 * a[e] + e1 * b[e] + e2 * c[e];
        *(u32x4*)(OATT + (size_t)m * 256 + hh * 64 + d8) = pack8(o);
    }
}


constexpr int LD = 72, MATB = 64 * LD * 2;
constexpr int SC_CUM = 13 * MATB;
constexpr int SC_SEG = SC_CUM + 16384;
constexpr int SC_WC = SC_SEG + 2048;
constexpr int SC_BS = SC_WC + 256;
constexpr int SC_KC = SC_BS + 256;
constexpr int SC_END = SC_KC + 1536;
static_assert(SC_END <= LDS_BYTES, "scan LDS map");
#define SLOT(i) ((LAS bf16_t*)(lds + (i) * MATB))

typedef short v4i16_t __attribute__((ext_vector_type(4)));
__device__ __forceinline__ bf16x8 tr_frag(const LAS bf16_t* base, int l15) {
    const LAS bf16_t* a = base + (l15 >> 2) * LD + (l15 & 3) * 4;
    const v4i16_t lo = __builtin_amdgcn_ds_read_tr16_b64_v4i16((LAS v4i16_t*)a), hi = __builtin_amdgcn_ds_read_tr16_b64_v4i16((LAS v4i16_t*)(a + 4 * LD));
    return (bf16x8){lo[0], lo[1], lo[2], lo[3], hi[0], hi[1], hi[2], hi[3]};
}
template <bool XT, bool NN> __device__ __forceinline__ void mm_block(const LAS bf16_t* X, const LAS bf16_t* Y, int it0, int jt0, int l15, int q4, f32x4 (&acc)[2][2]) {
#pragma unroll
    for (int s = 0; s < 2; ++s) {
        bf16x8 xf[2], yf[2];
#pragma unroll
        for (int a = 0; a < 2; ++a) { if (!XT) xf[a] = *(const LAS bf16x8*)(X + ((it0 + a) * 16 + l15) * LD + s * 32 + q4 * 8); else xf[a] = tr_frag(X + (s * 32 + q4 * 8) * LD + (it0 + a) * 16, l15); }
#pragma unroll
        for (int c = 0; c < 2; ++c) { if (!NN) yf[c] = *(const LAS bf16x8*)(Y + ((jt0 + c) * 16 + l15) * LD + s * 32 + q4 * 8); else yf[c] = tr_frag(Y + (s * 32 + q4 * 8) * LD + (jt0 + c) * 16, l15); }
#pragma unroll
        for (int a = 0; a < 2; ++a)
#pragma unroll
            for (int c = 0; c < 2; ++c) acc[a][c] = __builtin_amdgcn_mfma_f32_16x16x32_bf16(yf[c], xf[a], acc[a][c], 0, 0, 0);
    }
}
template <bool XT, bool NN> __device__ __forceinline__ void mm_row(const LAS bf16_t* X, const LAS bf16_t* Y, int it, int jt0, int l15, int q4, f32x4 (&acc)[2]) {
#pragma unroll
    for (int s = 0; s < 2; ++s) {
        bf16x8 xf, yf[2];
        if (!XT) xf = *(const LAS bf16x8*)(X + (it * 16 + l15) * LD + s * 32 + q4 * 8); else xf = tr_frag(X + (s * 32 + q4 * 8) * LD + it * 16, l15);
#pragma unroll
        for (int c = 0; c < 2; ++c) { if (!NN) yf[c] = *(const LAS bf16x8*)(Y + ((jt0 + c) * 16 + l15) * LD + s * 32 + q4 * 8); else yf[c] = tr_frag(Y + (s * 32 + q4 * 8) * LD + (jt0 + c) * 16, l15); }
#pragma unroll
        for (int c = 0; c < 2; ++c) acc[c] = __builtin_amdgcn_mfma_f32_16x16x32_bf16(yf[c], xf, acc[c], 0, 0, 0);
    }
}
template <bool XT, bool NN> __device__ __forceinline__ void mm_block_1s(const LAS bf16_t* X, const LAS bf16_t* Y, int it0, int jt0, int s, int l15, int q4, f32x4 (&acc)[2][2]) {
    bf16x8 xf[2], yf[2];
#pragma unroll
    for (int a = 0; a < 2; ++a) { if (!XT) xf[a] = *(const LAS bf16x8*)(X + ((it0 + a) * 16 + l15) * LD + s * 32 + q4 * 8); else xf[a] = tr_frag(X + (s * 32 + q4 * 8) * LD + (it0 + a) * 16, l15); }
#pragma unroll
    for (int c = 0; c < 2; ++c) { if (!NN) yf[c] = *(const LAS bf16x8*)(Y + ((jt0 + c) * 16 + l15) * LD + s * 32 + q4 * 8); else yf[c] = tr_frag(Y + (s * 32 + q4 * 8) * LD + (jt0 + c) * 16, l15); }
#pragma unroll
    for (int a = 0; a < 2; ++a)
#pragma unroll
        for (int c = 0; c < 2; ++c) acc[a][c] = __builtin_amdgcn_mfma_f32_16x16x32_bf16(yf[c], xf[a], acc[a][c], 0, 0, 0);
}
template <bool XT, bool NN> __device__ __forceinline__ void mm_row_1s(const LAS bf16_t* X, const LAS bf16_t* Y, int it, int jt0, int s, int l15, int q4, f32x4 (&acc)[2]) {
    bf16x8 xf, yf[2];
    if (!XT) xf = *(const LAS bf16x8*)(X + (it * 16 + l15) * LD + s * 32 + q4 * 8); else xf = tr_frag(X + (s * 32 + q4 * 8) * LD + it * 16, l15);
#pragma unroll
    for (int c = 0; c < 2; ++c) { if (!NN) yf[c] = *(const LAS bf16x8*)(Y + ((jt0 + c) * 16 + l15) * LD + s * 32 + q4 * 8); else yf[c] = tr_frag(Y + (s * 32 + q4 * 8) * LD + (jt0 + c) * 16, l15); }
#pragma unroll
    for (int c = 0; c < 2; ++c) acc[c] = __builtin_amdgcn_mfma_f32_16x16x32_bf16(yf[c], xf, acc[c], 0, 0, 0);
}
#define TRI_MM(XS, YS, INIT, STORE) do { const int role_ = wv & 3; \
    if (role_ == 0 || role_ == 3) { const int it0 = role_ ? 2 : 0, jtb = it0; f32x4 acc[2][2]; FOR_AC { BLK_IJ; acc[a][c] = INIT(i, j0); } \
        mm_block_1s<false, true>(XS, YS, it0, jtb, role_ ? 1 : 0, l15, q4, acc); FOR_AC { BLK_IJ; STORE(i, j0, acc[a][c]); } } \
    else { const int itr_ = role_ - 1; f32x4 acc[2]; _Pragma("unroll") for (int c = 0; c < 2; ++c) { const int i = itr_ * 16 + l15, j0 = (2 + c) * 16 + q4 * 4; acc[c] = INIT(i, j0); } \
        mm_row<false, true>(XS, YS, itr_, 2, l15, q4, acc); _Pragma("unroll") for (int c = 0; c < 2; ++c) { const int i = itr_ * 16 + l15, j0 = (2 + c) * 16 + q4 * 4; STORE(i, j0, acc[c]); } } } while (0)
#define INIT_ZERO(i, j0) ZERO4
#define FOR_AC _Pragma("unroll") for (int a = 0; a < 2; ++a) _Pragma("unroll") for (int c = 0; c < 2; ++c)
#define BLK_IJ const int i = (it0 + a) * 16 + l15, j0 = (jtb + c) * 16 + q4 * 4
__device__ __forceinline__ void st4bf(LAS bf16_t* p, const f32x4 a) { u32x2 w; w.x = pk2(a[0], a[1]); w.y = pk2(a[2], a[3]); *(LAS u32x2*)p = w; }
__device__ __forceinline__ f32x4 ld4bf(const LAS bf16_t* p) { const u32x2 w = *(const LAS u32x2*)p; return (f32x4){bf2f(w.x & 0xffffu), __uint_as_float(w.x & 0xffff0000u), bf2f(w.y & 0xffffu), __uint_as_float(w.y & 0xffff0000u)}; }
#define ZERO4 ((f32x4){0.f, 0.f, 0.f, 0.f})

struct ScanConst { int unused; };
struct ScanLoads { u32x4 xdw, xda, r0, k0, v0, r1, k1, v1; };
__device__ __forceinline__ void scan_issue(CP p, ScanLoads& L, int b, int h, int c) {
    const int tid = fresh_tid(), tt = tid >> 3, c8 = (tid & 7) * 8, ch = h * 64 + c8;
    const bf16_t* RKV = (const bf16_t*)(p->ws + WS_RKV); const bf16_t* LA = (const bf16_t*)(p->ws + WS_LA);
    const size_t m = (size_t)b * S + c * 64 + tt; const bool hasp = (c * 64 + tt) > 0; const u32x4 z = (u32x4){0u, 0u, 0u, 0u};
    L.xdw = *(const u32x4*)(LA + m * 256 + c8); L.xda = *(const u32x4*)(LA + m * 256 + 64 + c8);
    const bf16_t* rk = RKV + ((size_t)(b * 16 + h) * S + c * 64 + tt) * 192 + c8;
    L.r0 = *(const u32x4*)(rk); L.k0 = *(const u32x4*)(rk + 64); L.v0 = *(const u32x4*)(rk + 128);
    L.r1 = hasp ? *(const u32x4*)(rk - 192) : z; L.k1 = hasp ? *(const u32x4*)(rk - 128) : z; L.v1 = hasp ? *(const u32x4*)(rk - 64) : z;
}
__device__ __forceinline__ void scan_consts(CP p, LAS unsigned char* lds, ScanConst& K, int h) {
    const int tid = fresh_tid(), tt = tid >> 3, c8 = (tid & 7) * 8;
    const float* mu = p->in[10]; const float* k_k = p->in[16]; const float* k_a = p->in[17]; const float* r_k = p->in[18]; const bf16_t* WL1 = (const bf16_t*)(p->ws + WS_WL1);
    LAS float* KC = (LAS float*)(lds + SC_KC);
    if (tid < 64) { const int ch = h * 64 + tid; KC[tid] = mu[ch]; KC[64 + tid] = mu[1024 + ch]; KC[128 + tid] = mu[2048 + ch]; KC[192 + tid] = k_k[ch]; KC[256 + tid] = k_a[ch]; KC[320 + tid] = r_k[ch]; }
    *(LAS u32x4*)(SLOT(4) + tt * LD + c8) = *(const u32x4*)(WL1 + (size_t)(h * 64 + tt) * 128 + c8);
    *(LAS u32x4*)(SLOT(5) + tt * LD + c8) = *(const u32x4*)(WL1 + (size_t)(1024 + h * 64 + tt) * 128 + 64 + c8);
    (void)K;
}
__device__ __forceinline__ void scan_stage_x(LAS unsigned char* lds, const ScanLoads& L) { const int tid = fresh_tid(), tt = tid >> 3, c8 = (tid & 7) * 8;
    *(LAS u32x4*)(SLOT(7) + tt * LD + c8) = L.xdw; *(LAS u32x4*)(SLOT(9) + tt * LD + c8) = L.xda; }
__device__ __forceinline__ bf16_t* tm_blob(unsigned char* ws, int item) {
    constexpr int N0 = 2560, N1 = 1194;
    if (item < N0) return (bf16_t*)(ws + WS_WIN) + (size_t)item * 3072;
    if (item < N0 + N1) return (bf16_t*)(ws + 137 * MiB) + (size_t)(item - N0) * 3072;
    return (bf16_t*)(ws + 64 * MiB) + (size_t)(item - N0 - N1) * 3072;
}
__device__ __forceinline__ void tm_piece(int tid, int& blob_off, int& lds_off) {
    if (tid < 256) { const int r = tid >> 3, c = (tid & 7) * 8; blob_off = tid * 8; lds_off = r * LD + c; }
    else { const int t2 = tid - 256, r = 32 + (t2 >> 2), c = 32 + (t2 & 3) * 8; blob_off = 2048 + t2 * 8; lds_off = r * LD + c; }
}
template <int PASS> __device__ __forceinline__ void scan_front(CP p, LAS unsigned char* lds, const ScanConst& K, ScanLoads& L, int b, int h, int cn, int item, u32x2 sc0 = (u32x2){0u, 0u}, u32x2 sc1 = (u32x2){0u, 0u}, u32x4 tmv = (u32x4){0u, 0u, 0u, 0u}) {
    const int tid = fresh_tid(), lane = tid & 63, wv = tid >> 6, l15 = lane & 15, q4 = lane >> 4, it = wv >> 1, jt0 = (wv & 1) * 2;
    const int half = wv >> 2, it0 = ((wv & 3) >> 1) * 2, jtb = (wv & 1) * 2;
    const float* w0 = p->in[11]; const float* a0 = p->in[13];
    LAS float* CUM = (LAS float*)(lds + SC_CUM); LAS float* SEG = (LAS float*)(lds + SC_SEG); LAS float* WCl = (LAS float*)(lds + SC_WC); LAS float* BS = (LAS float*)(lds + SC_BS);
    const int tt = tid >> 3, c8 = (tid & 7) * 8;
    float rc[8], rp[8], kc[8], kp[8], vc[8], vp[8];
    unpack8(L.r0, rc); unpack8(L.k0, kc); unpack8(L.v0, vc); unpack8(L.r1, rp); unpack8(L.k1, kp); unpack8(L.v1, vp);
    { f32x4 acc[2][2] = {{ZERO4, ZERO4}, {ZERO4, ZERO4}};
      if (half == 0) { mm_block<false, false>(SLOT(7), SLOT(4), it0, jtb, l15, q4, acc);
          FOR_AC { BLK_IJ; const f32x4 wb = *(const f32x4*)(w0 + h * 64 + j0); const f32x4 v = acc[a][c];
              *(LAS f32x4*)(CUM + i * 64 + j0) = (f32x4){lwf(wb[0] + v[0]), lwf(wb[1] + v[1]), lwf(wb[2] + v[2]), lwf(wb[3] + v[3])}; } }
      else { mm_block<false, false>(SLOT(9), SLOT(5), it0, jtb, l15, q4, acc);
          FOR_AC { BLK_IJ; const f32x4 ab = *(const f32x4*)(a0 + h * 64 + j0); const f32x4 v = acc[a][c];
              st4bf(SLOT(3) + i * LD + j0, (f32x4){sigmoidf_(ab[0] + v[0]), sigmoidf_(ab[1] + v[1]), sigmoidf_(ab[2] + v[2]), sigmoidf_(ab[3] + v[3])}); } } }
    __syncthreads();
    { const int cc = tid & 63, sg = tid >> 6; float run = 0.f;
#pragma unroll
      for (int e = 0; e < 8; ++e) { run += CUM[(sg * 8 + e) * 64 + cc]; CUM[(sg * 8 + e) * 64 + cc] = run; }
      SEG[sg * 64 + cc] = run; }
    __syncthreads();
    {
        float av[8], cu[8], cpv[8];
        { const f32x4 a_lo = ld4bf(SLOT(3) + tt * LD + c8), a_hi = ld4bf(SLOT(3) + tt * LD + c8 + 4);
          *(f32x4*)av = a_lo; *(f32x4*)(av + 4) = a_hi;
          float off[8];
#pragma unroll
          for (int e = 0; e < 8; ++e) off[e] = 0.f;
          for (int s2 = 0; s2 < wv; ++s2) { const f32x4 o0 = *(const LAS f32x4*)(SEG + s2 * 64 + c8), o1 = *(const LAS f32x4*)(SEG + s2 * 64 + c8 + 4);
#pragma unroll
              for (int e = 0; e < 4; ++e) { off[e] += o0[e]; off[4 + e] += o1[e]; } }
          *(f32x4*)cu = *(const LAS f32x4*)(CUM + tt * 64 + c8); *(f32x4*)(cu + 4) = *(const LAS f32x4*)(CUM + tt * 64 + c8 + 4);
          if (tt & 7) { *(f32x4*)cpv = *(const LAS f32x4*)(CUM + (tt - 1) * 64 + c8); *(f32x4*)(cpv + 4) = *(const LAS f32x4*)(CUM + (tt - 1) * 64 + c8 + 4); }
          else {
#pragma unroll
              for (int e = 0; e < 8; ++e) cpv[e] = 0.f; }
#pragma unroll
          for (int e = 0; e < 8; ++e) { cu[e] += off[e]; cpv[e] += off[e]; } }
        const LAS float* KC = (const LAS float*)(lds + SC_KC) + c8;
#define KCV(a, e) KC[(a) * 64 + (e)]
        float rr[8], ks[8], vs[8], kk[8], ss = 0.f;
#pragma unroll
        for (int e = 0; e < 8; ++e) { rr[e] = rc[e] + (rp[e] - rc[e]) * KCV(0, e); ks[e] = kc[e] + (kp[e] - kc[e]) * KCV(1, e); vs[e] = vc[e] + (vp[e] - vc[e]) * KCV(2, e);
            kk[e] = ks[e] * KCV(3, e); ss += kk[e] * kk[e]; }
        ss = red8(ss); const float rn = __builtin_amdgcn_rsqf(fmaxf(ss, 1e-24f));
        float o_a[8], o_b[8], o_k[8], o_r[8], bsum = 0.f;
#pragma unroll
        for (int e = 0; e < 8; ++e) { const float kn = kk[e] * rn, km = ks[e] * (1.0f + (av[e] - 1.0f) * KCV(4, e));
            const float wi = __expf(cu[e]), we = __expf(cpv[e]), rwi = __builtin_amdgcn_rcpf(wi);
            o_a[e] = -kn * we; o_b[e] = kn * av[e] * rwi; o_k[e] = km * rwi; o_r[e] = rr[e] * wi; bsum += rr[e] * km * KCV(5, e);
            if (tt == 63) WCl[c8 + e] = wi; }
        *(LAS u32x4*)(SLOT(0) + tt * LD + c8) = pack8(o_a); *(LAS u32x4*)(SLOT(1) + tt * LD + c8) = pack8(o_b); *(LAS u32x4*)(SLOT(2) + tt * LD + c8) = pack8(o_k);
        if (PASS == 3) { *(LAS u32x4*)(SLOT(3) + tt * LD + c8) = pack8(o_r); bsum = red8(bsum); if ((tid & 7) == 0) BS[tt] = bsum; }
        *(LAS u32x4*)(SLOT(6) + tt * LD + c8) = pack8(vs);
    }
    if (cn >= 0) scan_issue(p, L, b, h, cn);
    __syncthreads();
    if (PASS == 1) {
    { f32x4 acc[2][2] = {{ZERO4, ZERO4}, {ZERO4, ZERO4}};
      if (half == 0) { mm_block<false, false>(SLOT(1), SLOT(0), it0, jtb, l15, q4, acc);
          FOR_AC { BLK_IJ; f32x4 v = acc[a][c], t0;
#pragma unroll
              for (int e = 0; e < 4; ++e) { v[e] = (i < j0 + e) ? v[e] : 0.f; t0[e] = (i == j0 + e) ? 1.0f : v[e]; }
              st4bf(SLOT(7) + i * LD + j0, v); st4bf(SLOT(10) + i * LD + j0, t0); } }
      else { mm_block<false, false>(SLOT(2), SLOT(0), it0, jtb, l15, q4, acc);
          FOR_AC { BLK_IJ; f32x4 v = acc[a][c];
#pragma unroll
              for (int e = 0; e < 4; ++e) v[e] = (i < j0 + e) ? v[e] : 0.f;
              st4bf(SLOT(12) + i * LD + j0, v); } } }
    __syncthreads();
    if (half == 0) {
#define STORE_N1(i, j0, v) st4bf(SLOT(8) + (i) * LD + (j0), v)
        TRI_MM(SLOT(7), SLOT(7), INIT_ZERO, STORE_N1); }
    __syncthreads();
#define NEU_STEP3(TSRC, TDST, NCUR, NNEXT) do { \
        if (half == 0) { TRI_MM(SLOT(TSRC), SLOT(NCUR), [&](int i_, int j_) { return ld4bf(SLOT(TSRC) + i_ * LD + j_); }, [&](int i_, int j_, f32x4 v_) { st4bf(SLOT(TDST) + i_ * LD + j_, v_); }); } \
        else { TRI_MM(SLOT(NCUR), SLOT(NCUR), INIT_ZERO, [&](int i_, int j_, f32x4 v_) { st4bf(SLOT(NNEXT) + i_ * LD + j_, v_); }); } \
        __syncthreads(); } while (0)
    NEU_STEP3(10, 11, 8, 9);
    NEU_STEP3(11, 10, 9, 8);
    NEU_STEP3(10, 11, 8, 9);
    NEU_STEP3(11, 10, 9, 8);
    if (half == 0) { TRI_MM(SLOT(10), SLOT(8), [&](int i_, int j_) { return ld4bf(SLOT(10) + i_ * LD + j_); }, [&](int i_, int j_, f32x4 v_) { st4bf(SLOT(11) + i_ * LD + j_, v_); }); }
    __syncthreads();
    if (tid < 384) { int bo, lo; tm_piece(tid, bo, lo); *(u32x4*)(tm_blob(p->ws, item) + bo) = *(const LAS u32x4*)(SLOT(11) + lo); }
    } else {
    if (half != 0) { f32x4 acc[2][2] = {{ZERO4, ZERO4}, {ZERO4, ZERO4}}; mm_block<false, false>(SLOT(2), SLOT(0), it0, jtb, l15, q4, acc);
        FOR_AC { BLK_IJ; f32x4 v = acc[a][c];
#pragma unroll
            for (int e = 0; e < 4; ++e) v[e] = (i < j0 + e) ? v[e] : 0.f;
            st4bf(SLOT(12) + i * LD + j0, v); } }
    if (tid < 384) { int bo, lo; tm_piece(tid, bo, lo); *(LAS u32x4*)(SLOT(11) + lo) = tmv; }
    __syncthreads();
    }
    { if (half == 0) { f32x4 acc[2][2] = {{ZERO4, ZERO4}, {ZERO4, ZERO4}};
          if (jtb == 0) mm_block_1s<true, true>(SLOT(0), SLOT(11), it0, jtb, 0, l15, q4, acc); else mm_block<true, true>(SLOT(0), SLOT(11), it0, jtb, l15, q4, acc);
          FOR_AC { BLK_IJ; st4bf(SLOT(7) + i * LD + j0, acc[a][c]); }
          if (PASS == 3) { FOR_AC { acc[a][c] = ZERO4; } mm_block<false, false>(SLOT(1), SLOT(3), it0, jtb, l15, q4, acc);
              FOR_AC { BLK_IJ; f32x4 v = acc[a][c];
#pragma unroll
                  for (int e = 0; e < 4; ++e) v[e] = (i <= j0 + e) ? v[e] : 0.f;
                  st4bf((LAS bf16_t*)(lds + SC_CUM) + i * LD + j0, v); } } }
      else { TRI_MM(SLOT(12), SLOT(11), INIT_ZERO, [&](int i_, int j_, f32x4 v_) { st4bf(SLOT(9) + i_ * LD + j_, v_); });
          if (PASS == 3) { f32x4 acc[2][2] = {{ZERO4, ZERO4}, {ZERO4, ZERO4}}; mm_block<false, false>(SLOT(2), SLOT(3), it0, jtb, l15, q4, acc);
              FOR_AC { BLK_IJ; f32x4 v = acc[a][c];
#pragma unroll
                  for (int e = 0; e < 4; ++e) v[e] = (i <= j0 + e) ? v[e] : 0.f;
                  st4bf(SLOT(8) + i * LD + j0, v); } } } }
    if (PASS == 3) {
        const int vbmt = tid >> 6; *(LAS u32x2*)(SLOT(10) + ((vbmt >> 2) * 16 + (lane & 15)) * LD + (vbmt & 3) * 16 + (lane >> 4) * 4) = sc0;
        const int vbmt1 = vbmt + 8; *(LAS u32x2*)(SLOT(10) + ((vbmt1 >> 2) * 16 + (lane & 15)) * LD + (vbmt1 & 3) * 16 + (lane >> 4) * 4) = sc1; }
    __syncthreads();
}

__device__ __forceinline__ void phase_scanA(CP p, LAS unsigned char* lds) {
    const int tid = fresh_tid(), lane = tid & 63, wv = tid >> 6, l15 = lane & 15, q4 = lane >> 4, it = wv >> 1, jt0 = (wv & 1) * 2;
    bf16_t* G1P = (bf16_t*)(p->ws + WS_G1P); bf16_t* SPP = (bf16_t*)(p->ws + WS_SPP); float* WC = (float*)(p->ws + WS_WC);
    LAS float* WCl = (LAS float*)(lds + SC_WC);
    const int bh = blockIdx.x >> 3, b = bh >> 4, h = bh & 15, cb = blockIdx.x & 7;
    ScanConst K; ScanLoads L;
    scan_consts(p, lds, K, h); scan_issue(p, L, b, h, cb); scan_stage_x(lds, L); __syncthreads();
    for (int i = 0; i < 16; ++i) {
        const int c = cb + 8 * i, item = bh * 128 + c;
        scan_front<1>(p, lds, K, L, b, h, i < 15 ? c + 8 : -1, item);
        if (tid < 64) WC[(size_t)item * 64 + tid] = WCl[tid];
        { const int half = wv >> 2, it0 = ((wv & 3) >> 1) * 2, jtb = (wv & 1) * 2; f32x4 acc[2][2];
          if (half == 0) { FOR_AC { acc[a][c] = ZERO4; } mm_block<true, false>(SLOT(1), SLOT(7), it0, jtb, l15, q4, acc);
              FOR_AC { const int itt = it0 + a, jt = jtb + c; const float wi = WCl[itt * 16 + l15]; const f32x4 v = acc[a][c];
                  u32x2 w; w.x = pk2(v[0] * wi, v[1] * wi); w.y = pk2(v[2] * wi, v[3] * wi);
                  *(u32x2*)(G1P + (size_t)item * 4096 + ((itt * 2 + (jt >> 1)) * 64 + lane) * 8 + (jt & 1) * 4) = w; } }
          else { FOR_AC { BLK_IJ; acc[a][c] = ld4bf(SLOT(2) + i * LD + j0); }
              if (it0 == 2) mm_block_1s<false, true>(SLOT(9), SLOT(1), it0, jtb, 1, l15, q4, acc); else mm_block<false, true>(SLOT(9), SLOT(1), it0, jtb, l15, q4, acc);
              FOR_AC { BLK_IJ; st4bf(SLOT(10) + i * LD + j0, acc[a][c]); } } }
        __syncthreads();
        { f32x4 acc[2] = {ZERO4, ZERO4}; mm_row<true, true>(SLOT(6), SLOT(10), it, jt0, l15, q4, acc);
#pragma unroll
          for (int c = 0; c < 2; ++c) { const int jt = jt0 + c, j0 = jt * 16 + q4 * 4; const f32x4 wc4 = *(const LAS f32x4*)(WCl + j0); const f32x4 v = acc[c];
              u32x2 w; w.x = pk2(v[0] * wc4[0], v[1] * wc4[1]); w.y = pk2(v[2] * wc4[2], v[3] * wc4[3]);
              *(u32x2*)(SPP + (size_t)item * 4096 + ((it * 4 + jt) * 64 + lane) * 4) = w; } }
        if (i < 15) scan_stage_x(lds, L);
        __syncthreads();
    }
}

template <bool DRY> __device__ __forceinline__ void phase_scanB(CP p, LAS unsigned char* lds) {
    if (blockIdx.x >= 32) return;
    const int tid = fresh_tid(), lane = tid & 63, wv = tid >> 6, q4 = lane >> 4;
    const bf16_t* G1P = (const bf16_t*)(p->ws + WS_G1P); bf16_t* SPP = (bf16_t*)(p->ws + WS_SPP); const float* WC = (const float*)(p->ws + WS_WC);
    const int bh = blockIdx.x, vb = wv;
    constexpr int CB = 16640, HB = 4 * CB;
    static_assert(2 * HB <= LDS_BYTES, "pass B LDS");
    u32x4 g[4], s[4]; f32x4 wreg = ZERO4;
#define SB_ISSUE(r) do { _Pragma("unroll") for (int ci = 0; ci < 4; ++ci) { const size_t item = (size_t)bh * 128 + (r) * 4 + ci; g[ci] = *(const u32x4*)(G1P + item * 4096 + tid * 8); s[ci] = *(const u32x4*)(SPP + item * 4096 + tid * 8); } \
        if (tid < 64) wreg = *(const f32x4*)(WC + ((size_t)bh * 128 + (r) * 4 + (tid >> 4)) * 64 + (tid & 15) * 4); } while (0)
#define SB_COMMIT(hf) do { LAS unsigned char* base = lds + (hf) * HB; _Pragma("unroll") for (int ci = 0; ci < 4; ++ci) { *(LAS u32x4*)(base + ci * CB + tid * 16) = g[ci]; *(LAS u32x4*)(base + ci * CB + 8192 + tid * 16) = s[ci]; } \
        if (tid < 64) *(LAS f32x4*)(base + (tid >> 4) * CB + 16384 + (tid & 15) * 16) = wreg; } while (0)
    SB_ISSUE(0); SB_COMMIT(0); __syncthreads();
    f32x4 st[4] = {ZERO4, ZERO4, ZERO4, ZERO4};
    for (int r = 0; r < 32; ++r) {
        if (r + 1 < 32) SB_ISSUE(r + 1);
        if (wv < 4) {
            const LAS unsigned char* base = lds + (r & 1) * HB;
#pragma unroll
            for (int ci = 0; ci < 4; ++ci) { const LAS unsigned char* cbp = base + ci * CB; const size_t item = (size_t)bh * 128 + r * 4 + ci;
                bf16x8 bfr[2];
#pragma unroll
                for (int s2 = 0; s2 < 2; ++s2) { u32x4 o; o.x = pk2(st[2 * s2][0], st[2 * s2][1]); o.y = pk2(st[2 * s2][2], st[2 * s2][3]); o.z = pk2(st[2 * s2 + 1][0], st[2 * s2 + 1][1]); o.w = pk2(st[2 * s2 + 1][2], st[2 * s2 + 1][3]); bfr[s2] = __builtin_bit_cast(bf16x8, o); }
#pragma unroll
                for (int mt = 0; mt < 4; ++mt) { const u32x4 bw = __builtin_bit_cast(u32x4, bfr[mt >> 1]); u32x2 o; o.x = (mt & 1) ? bw.z : bw.x; o.y = (mt & 1) ? bw.w : bw.y;
                    if (!DRY) *(u32x2*)(SPP + item * 4096 + ((vb * 4 + mt) * 64 + lane) * 4) = o; }
#pragma unroll
                for (int mt = 0; mt < 4; ++mt) {
                    const bf16x8 a0 = *(const LAS bf16x8*)(cbp + ((mt * 2 + 0) * 64 + lane) * 16), a1 = *(const LAS bf16x8*)(cbp + ((mt * 2 + 1) * 64 + lane) * 16);
                    const u32x2 sp = *(const LAS u32x2*)(cbp + 8192 + ((vb * 4 + mt) * 64 + lane) * 8); const f32x4 w = *(const LAS f32x4*)(cbp + 16384 + (mt * 16 + q4 * 4) * 4);
                    f32x4 acc = ZERO4;
                    acc = __builtin_amdgcn_mfma_f32_16x16x32_bf16(a0, bfr[0], acc, 0, 0, 0); acc = __builtin_amdgcn_mfma_f32_16x16x32_bf16(a1, bfr[1], acc, 0, 0, 0);
                    const f32x4 spv = (f32x4){bf2f(sp.x & 0xffffu), __uint_as_float(sp.x & 0xffff0000u), bf2f(sp.y & 0xffffu), __uint_as_float(sp.y & 0xffff0000u)};
                    st[mt] = acc + w * st[mt] + spv; }
            }
        }
        if (r + 1 < 32) SB_COMMIT((r + 1) & 1);
        __syncthreads();
    }
    if (DRY && wv < 4) { float* dump = (float*)(p->ws + WS_WC + 2 * MiB) + ((size_t)bh * 4 + vb) * 1024 + lane * 16;
#pragma unroll
        for (int mt = 0; mt < 4; ++mt) *(f32x4*)(dump + mt * 4) = st[mt]; }
#undef SB_ISSUE
#undef SB_COMMIT
}

__device__ __forceinline__ void phase_scanC(CP p, LAS unsigned char* lds) {
    const int tid = fresh_tid(), lane = tid & 63, wv = tid >> 6, l15 = lane & 15, q4 = lane >> 4, it = wv >> 1, jt0 = (wv & 1) * 2;
    const bf16_t* SPP = (const bf16_t*)(p->ws + WS_SPP); const bf16_t* LA = (const bf16_t*)(p->ws + WS_LA); const bf16_t* WL2 = (const bf16_t*)(p->ws + WS_WL2); bf16_t* ORW = (bf16_t*)(p->ws + WS_ORW);
    const float* gn_w = p->in[19]; const float* gn_b = p->in[20];
    LAS float* YT = (LAS float*)(lds + SC_CUM); LAS float* BS = (LAS float*)(lds + SC_BS);
    const int tt = tid >> 3, c8 = (tid & 7) * 8;
    const int bh = blockIdx.x >> 3, b = bh >> 4, h = bh & 15, cb = blockIdx.x & 7, ch = h * 64 + c8;
    ScanConst K; ScanLoads L;
    scan_consts(p, lds, K, h); scan_issue(p, L, b, h, cb); scan_stage_x(lds, L); __syncthreads();
    for (int i = 0; i < 16; ++i) {
        const int c = cb + 8 * i, item = bh * 128 + c;
        const size_t m = (size_t)b * S + c * 64 + tt;
        const u32x2 sc0 = *(const u32x2*)(SPP + (size_t)item * 4096 + (size_t)tid * 4), sc1 = *(const u32x2*)(SPP + (size_t)item * 4096 + (size_t)(tid + 512) * 4);
        u32x4 tmv = (u32x4){0u, 0u, 0u, 0u};
        if (tid < 384) { int bo, lo; tm_piece(tid, bo, lo); tmv = *(const u32x4*)(tm_blob(p->ws, item) + bo); }
        scan_front<3>(p, lds, K, L, b, h, i < 15 ? c + 8 : -1, item, sc0, sc1, tmv);
        const u32x4 xg0 = *(const u32x4*)(LA + m * 256 + 128 + c8), xg1 = *(const u32x4*)(LA + m * 256 + 192 + c8);
        const u32x4 gw0 = *(const u32x4*)(WL2 + (size_t)(h * 64 + tt) * 128 + c8), gw1 = *(const u32x4*)(WL2 + (size_t)(h * 64 + tt) * 128 + 64 + c8);
        const LAS bf16_t* ARBS = (const LAS bf16_t*)(lds + SC_CUM);
        { const int half = wv >> 2, it0 = ((wv & 3) >> 1) * 2, jtb = (wv & 1) * 2; f32x4 acc[2][2];
          if (half == 0) { FOR_AC { BLK_IJ; acc[a][c] = (f32x4){bf2f((unsigned)SLOT(3)[(j0 + 0) * LD + i]), bf2f((unsigned)SLOT(3)[(j0 + 1) * LD + i]), bf2f((unsigned)SLOT(3)[(j0 + 2) * LD + i]), bf2f((unsigned)SLOT(3)[(j0 + 3) * LD + i])}; }
              if (jtb == 0) mm_block_1s<false, true>(SLOT(7), ARBS, it0, jtb, 0, l15, q4, acc); else mm_block<false, true>(SLOT(7), ARBS, it0, jtb, l15, q4, acc);
              FOR_AC { BLK_IJ; st4bf(SLOT(11) + i * LD + j0, acc[a][c]); } }
          else { TRI_MM(SLOT(9), ARBS, [&](int i_, int j_) { return ld4bf(SLOT(8) + i_ * LD + j_); }, [&](int i_, int j_, f32x4 v_) { st4bf(SLOT(12) + i_ * LD + j_, v_); }); } }
        __syncthreads();
        { f32x4 acc[2] = {ZERO4, ZERO4}; mm_row<false, true>(SLOT(10), SLOT(11), it, jt0, l15, q4, acc);
          if (jt0 == 0) mm_row_1s<true, true>(SLOT(6), SLOT(12), it, jt0, 0, l15, q4, acc); else mm_row<true, true>(SLOT(6), SLOT(12), it, jt0, l15, q4, acc);
#pragma unroll
          for (int c = 0; c < 2; ++c) { const int i2 = it * 16 + l15, j0 = (jt0 + c) * 16 + q4 * 4;
#pragma unroll
              for (int e = 0; e < 4; ++e) YT[(j0 + e) * 64 + i2] = acc[c][e]; } }
        *(LAS u32x4*)(SLOT(7) + tt * LD + c8) = xg0; *(LAS u32x4*)(SLOT(8) + tt * LD + c8) = xg1;
        *(LAS u32x4*)(SLOT(0) + tt * LD + c8) = gw0; *(LAS u32x4*)(SLOT(9) + tt * LD + c8) = gw1;
        __syncthreads();
        { f32x4 acc[2] = {ZERO4, ZERO4}; mm_row<false, false>(SLOT(7), SLOT(0), it, jt0, l15, q4, acc); mm_row<false, false>(SLOT(8), SLOT(9), it, jt0, l15, q4, acc);
#pragma unroll
          for (int c = 0; c < 2; ++c) st4bf(SLOT(11) + (it * 16 + l15) * LD + (jt0 + c) * 16 + q4 * 4, acc[c]); }
        __syncthreads();
        {
            float y[8], g[8], vv[8], o[8], gnw[8], gnb[8];
            *(f32x4*)gnw = *(const f32x4*)(gn_w + ch); *(f32x4*)(gnw + 4) = *(const f32x4*)(gn_w + ch + 4); *(f32x4*)gnb = *(const f32x4*)(gn_b + ch); *(f32x4*)(gnb + 4) = *(const f32x4*)(gn_b + ch + 4);
            *(f32x4*)y = *(const LAS f32x4*)(YT + tt * 64 + c8); *(f32x4*)(y + 4) = *(const LAS f32x4*)(YT + tt * 64 + c8 + 4);
            *(f32x4*)g = ld4bf(SLOT(11) + tt * LD + c8); *(f32x4*)(g + 4) = ld4bf(SLOT(11) + tt * LD + c8 + 4);
            unpack8(*(const LAS u32x4*)(SLOT(6) + tt * LD + c8), vv);
            float sm = 0.f;
#pragma unroll
            for (int e = 0; e < 8; ++e) sm += y[e];
            const float mean = red8(sm) * (1.f / 64.f); float sq = 0.f;
#pragma unroll
            for (int e = 0; e < 8; ++e) { y[e] -= mean; sq += y[e] * y[e]; }
            const float rstd = __builtin_amdgcn_rsqf(red8(sq) * (1.f / 64.f) + GN_EPS), bs = BS[tt];
#pragma unroll
            for (int e = 0; e < 8; ++e) o[e] = (y[e] * rstd * gnw[e] + gnb[e] + bs * vv[e]) * g[e];
            *(u32x4*)(ORW + m * 1024 + ch) = pack8(o);
        }
        if (i < 15) scan_stage_x(lds, L);
        __syncthreads();
    }
}

__global__ void __launch_bounds__(512, 2) fwd_megakernel(Params p_unused) {
    extern __shared__ __attribute__((aligned(16))) unsigned char lds_raw[];
    LAS unsigned char* lds = (LAS unsigned char*)lds_raw;
    volatile LAS unsigned* bst = (volatile LAS unsigned*)(lds + LDS_BYTES - 16);
    if (threadIdx.x < 4) bst[threadIdx.x] = 0u;
    __syncthreads();
    const XcdBarrier gbar = xcd_barrier_post((unsigned*)(get_params()->ws + WS_CTL), bst);
    phase0(get_params(), lds);
    xcd_barrier(gbar);
    phase_wt(get_params(), lds, 0, 0);
    phase_h(get_params());
    xcd_barrier(gbar);
    {
        CP p = get_params(); unsigned char* ws = p->ws;
        FInProj f{(bf16_t*)(ws + WS_QKV), (bf16_t*)(ws + WS_RKV), (bf16_t*)(ws + WS_LRAW), (bf16_t*)p->out};
        run_gemm(lds, (const bf16_t*)(ws + WS_H), 1024, (const bf16_t*)(ws + WS_WIN), 1024, NIN, 1024, f);
    }
    xcd_barrier(gbar);
    phase_attn(get_params(), lds);
    phase_prep(get_params());
    xcd_barrier(gbar);
    phase_scanA(get_params(), lds);
    xcd_barrier(gbar);
    phase_scanB<false>(get_params(), lds);
    if (blockIdx.x >= 32) { phase_combine(get_params(), 32); phase_wt(get_params(), lds, 1, 32); }
    xcd_barrier(gbar);
    phase_scanC(get_params(), lds);
    xcd_barrier(gbar);
    {
        CP p = get_params(); unsigned char* ws = p->ws;
        FM1 f1{(const bf16_t*)p->out, (bf16_t*)(ws + WS_MRG)};
        run_gemm(lds, (const bf16_t*)(ws + WS_OATT), 256, (const bf16_t*)(ws + WS_WBR), 1280, 1024, 256, f1);
        FM2 f2{(const bf16_t*)p->out, (const bf16_t*)(ws + WS_MRG), (bf16_t*)(ws + WS_MERGED)};
        run_gemm(lds, (const bf16_t*)(ws + WS_ORW), 1024, (const bf16_t*)(ws + WS_WBR) + 256, 1280, 1024, 1024, f2);
    }
    xcd_barrier(gbar);
    {   CP p = get_params(); unsigned char* ws = p->ws;
        EpiRow1 e{p->in[0], p->out, (bf16_t*)(ws + WS_H2), (const float*)(ws + WS_MOD), p->in[6], p->in[7], PanelX<2>{(unsigned long long*)(ws + WS_XB1), (unsigned*)(ws + WS_CTL + 16384)}};
        run_gemm_fused(lds, (const bf16_t*)(ws + WS_MERGED), 1024, (const bf16_t*)(ws + WS_WOUT), 1024, 1024, 1024, e); }
    xcd_barrier(gbar);
    {   unsigned char* ws = get_params()->ws; FRelu2 f{(bf16_t*)(ws + WS_FFH), FF};
        run_gemm(lds, (const bf16_t*)(ws + WS_H2), 1024, (const bf16_t*)(ws + WS_WFF1), 1024, FF, 1024, f); }
    xcd_barrier(gbar);
    {   CP p = get_params(); unsigned char* ws = p->ws;
        EpiRow2 e{p->out, (const float*)(ws + WS_MOD), p->in[8], PanelX<1>{(unsigned long long*)(ws + WS_XB2), (unsigned*)(ws + WS_CTL + 32768)}};
        run_gemm_fused(lds, (const bf16_t*)(ws + WS_FFH), FF, (const bf16_t*)(ws + WS_WFF2), FF, 1024, FF, e); }
}

extern "C" void kernel_launch(void* const* d_in, const int* in_sizes, int n_in, void* d_out, int out_size, void* d_ws, size_t ws_size, hipStream_t stream) {
    static int grid = 0;
    if (grid == 0) {
        if (n_in != 25 || out_size != M * D || ws_size < WS_END) { fprintf(stderr, "kernel_launch: unexpected shapes n_in %d out %d ws %zu\n", n_in, out_size, ws_size); grid = -1; return; }
        int dev = 0, cus = 0, per_cu = 0;
        hipGetDevice(&dev); hipDeviceGetAttribute(&cus, hipDeviceAttributeMultiprocessorCount, dev);
        hipFuncSetAttribute((const void*)fwd_megakernel, hipFuncAttributeMaxDynamicSharedMemorySize, LDS_BYTES);
        hipOccupancyMaxActiveBlocksPerMultiprocessor(&per_cu, (const void*)fwd_megakernel, 512, LDS_BYTES);
        if (per_cu < 1) { fprintf(stderr, "kernel_launch: occupancy query says %d blocks per CU\n", per_cu); per_cu = 1; }
        grid = cus * 1;
        if (grid != 256) { fprintf(stderr, "kernel_launch: this kernel's scan passes are laid out for a 256-CU grid, got %d CUs\n", cus); grid = -1; return; }
        fprintf(stderr, "kernel_launch: cus %d per_cu %d grid %d\n", cus, per_cu, grid);
    }
    if (grid < 0) return;
    Params p{};
    for (int i = 0; i < 25; ++i) p.in[i] = (const float*)d_in[i];
    p.out = (float*)d_out; p.ws = (unsigned char*)d_ws;
    if (hipMemsetAsync((char*)d_ws + WS_CTL, 0, CTL_BYTES, stream) != hipSuccess) { fprintf(stderr, "kernel_launch: memset of the barrier words failed\n"); return; }
    hipLaunchKernelGGL(fwd_megakernel, dim3(grid), dim3(512), LDS_BYTES, stream, p);
    const hipError_t e = hipPeekAtLastError();
    if (e != hipSuccess) fprintf(stderr, "launch failed: %s (grid %d)\n", hipGetErrorString(e), grid);
}
```

```cpp
#include <hip/hip_runtime.h>
#include <cstdio>
#include <cstdint>

namespace pg8 {
#define PG8_LAS __attribute__((address_space(3)))
typedef unsigned short bf16_t;
typedef short bf16x8 __attribute__((ext_vector_type(8)));
typedef float f32x4 __attribute__((ext_vector_type(4)));
typedef unsigned u32x4 __attribute__((ext_vector_type(4)));
constexpr int BM = 256, BK = 64, HALF = 128, HTB = HALF * BK * 2  , STAGE_BYTES = 8 * HTB, NXCD = 8, WGM = 4;

__host__ __device__ __forceinline__ int lds_byte(int r, int c) { const int st = (r >> 4) * 2 + (c >> 5), rr = r & 15, cc = c & 31, ob = rr * 64 + cc * 2; return st * 1024 + (ob ^ (((ob >> 9) & 1) << 5)); }
__host__ __device__ __forceinline__ void stage_rc(int b, int& R, int& C) { const int st = b / 1024, sb = b % 1024, swz = sb ^ (((sb >> 9) & 1) << 5); R = (st >> 1) * 16 + swz / 64; C = (st & 1) * 32 + (swz % 64) / 2; }
__host__ __device__ __forceinline__ int perm32(int rho) { const int n = rho >> 4, i = rho & 15; return 8 * (i >> 2) + 4 * n + (i & 3); }

struct Unit { int pm, pn; };
struct Gemm { const bf16_t* A; const bf16_t* Bt; int M, N, K, lda, ldb; };

struct StaticOrder {
    int nM, nN, nwg, G, c;
    __host__ __device__ void init(int M, int N, int G_, int c_) { nM = M / BM; nN = N / BM; nwg = nM * nN; G = G_; c = c_; }
    __host__ __device__ bool next(int i, Unit& u) const {
        const long L = (long)i * G + c; if (L >= nwg) return false;
        int wgid = (int)L; { const int q = nwg / NXCD, r = nwg % NXCD, xcd = wgid % NXCD, off = wgid / NXCD; wgid = (xcd < r ? xcd * (q + 1) : r * (q + 1) + (xcd - r) * q) + off; }
        const int nig = WGM * nN, gid = wgid / nig, fm = gid * WGM, gsz = (nM - fm) < WGM ? (nM - fm) : WGM;
        u.pm = fm + ((wgid % nig) % gsz); u.pn = (wgid % nig) / gsz; return true;
    }
    __device__ __forceinline__ void a_ready(const Unit&) const {}
    __device__ __forceinline__ void done(const Unit&) const {}
};

template <class F> struct EpiG {
    static constexpr bool PERM = true, AFTER_DRAIN = false;
    F f;
    __device__ __forceinline__ void operator()(const f32x4 (&acc)[2][2][4][2], const Unit& u, int wr, int wc, int fr, int fq) const {
        const int row0 = u.pm * BM + wr * 64 + fr, col0 = u.pn * BM + wc * 32 + 8 * fq;
#pragma unroll
        for (int ai = 0; ai < 2; ++ai)
#pragma unroll
            for (int m = 0; m < 4; ++m)
#pragma unroll
                for (int bj = 0; bj < 2; ++bj) f(row0 + ai * HALF + m * 16, col0 + bj * HALF, acc[ai][bj][m][0], acc[ai][bj][m][1]);
    }
};

template <class Epi, class Sched, bool ALIGN_EPI = false, bool SP2 = false>
__device__ __forceinline__ void gemm_phase(PG8_LAS unsigned char* lds, const Gemm g, const Sched& S, const Epi& E) {
    int tid_ = threadIdx.x; asm volatile("" : "+v"(tid_));
    const int tid = tid_, wid = __builtin_amdgcn_readfirstlane(tid >> 6), lane = tid & 63, wr = wid >> 2, wc = wid & 3, fr = lane & 15, fq = lane >> 4;
    const int K = g.K, nt = K / BK;
    unsigned voffA[2], voffB[2];
#pragma unroll
    for (int i = 0; i < 2; ++i) { int R, C; stage_rc(tid * 16 + i * 8192, R, C); const int Rb = Epi::PERM ? ((R & ~31) + perm32(R & 31)) : R;
        voffA[i] = (unsigned)(R * g.lda + C) * 2u; voffB[i] = (unsigned)(Rb * g.ldb + C) * 2u; }
    const size_t kstep = (size_t)(BK * 2);
    const size_t hstepA = (size_t)HALF * g.lda * 2, hstepB = (size_t)HALF * g.ldb * 2;
    const size_t tstepA = 2 * hstepA, tstepB = 2 * hstepB;
    const unsigned ldsw = (unsigned)wid * 1024u;
    const int aoff = lds_byte(wr * 64 + fr, fq * 8), boff = lds_byte(wc * 32 + fr, fq * 8);
#define PG8_SA(b, h) (((b) * 2 + (h)) * HTB)
#define PG8_SB(b, h) ((4 + (b) * 2 + (h)) * HTB)
#define PG8_STAGE(bufoff, gbase, voff) do { _Pragma("unroll") for (int _i = 0; _i < 2; ++_i) \
        __builtin_amdgcn_global_load_lds((const unsigned*)((const char*)(gbase) + (voff)[_i]), (PG8_LAS unsigned*)(lds + (bufoff) + ldsw + _i * 8192), 16, 0, 0); } while (0)
#define PG8_LDA(dst, b, h) do { _Pragma("unroll") for (int m = 0; m < 4; ++m) _Pragma("unroll") for (int k = 0; k < 2; ++k) dst[m][k] = *(const PG8_LAS bf16x8*)(lds + PG8_SA(b, h) + aoff + m * 2048 + k * 1024); } while (0)
#define PG8_LDB(dst, b, h) do { _Pragma("unroll") for (int n = 0; n < 2; ++n) _Pragma("unroll") for (int k = 0; k < 2; ++k) dst[n][k] = *(const PG8_LAS bf16x8*)(lds + PG8_SB(b, h) + boff + n * 2048 + k * 1024); } while (0)
#define PG8_MMA(ai, bj, At, Bt) do { __builtin_amdgcn_s_setprio(1); _Pragma("unroll") for (int m = 0; m < 4; ++m) _Pragma("unroll") for (int n = 0; n < 2; ++n) _Pragma("unroll") for (int k = 0; k < 2; ++k) \
        acc[ai][bj][m][n] = __builtin_amdgcn_mfma_f32_16x16x32_bf16(Bt[n][k], At[m][k], acc[ai][bj][m][n], 0, 0, 0); __builtin_amdgcn_s_setprio(0); } while (0)
#define PG8_WAIT_V(n) asm volatile("s_waitcnt vmcnt(" #n ")" ::: "memory")
#define PG8_WAIT_L(n) asm volatile("s_waitcnt lgkmcnt(" #n ")" ::: "memory")
#define PG8_BAR __builtin_amdgcn_s_barrier()
#define PG8_SCHED __builtin_amdgcn_sched_barrier(0)
    Unit cur, nxt; int ui = 0;
    if (!S.next(0, cur)) return;
    f32x4 acc[2][2][4][2];
#pragma unroll
    for (int a = 0; a < 2; ++a)
#pragma unroll
        for (int b = 0; b < 2; ++b)
#pragma unroll
            for (int m = 0; m < 4; ++m)
#pragma unroll
                for (int n = 0; n < 2; ++n) acc[a][b][m][n] = (f32x4){0.f, 0.f, 0.f, 0.f};
    bf16x8 At[4][2], B0[2][2], B1[2][2];
    const char* cA = (const char*)g.A + (size_t)cur.pm * tstepA; const char* cB = (const char*)g.Bt + (size_t)cur.pn * tstepB;
    S.a_ready(cur);
    if constexpr (SP2) {
        PG8_STAGE(PG8_SB(0, 0), cB, voffB); PG8_STAGE(PG8_SB(0, 1), cB + hstepB, voffB); PG8_STAGE(PG8_SA(0, 0), cA, voffA); PG8_STAGE(PG8_SA(0, 1), cA + hstepA, voffA);
        if (wr == 1) PG8_BAR;
        PG8_WAIT_V(2); PG8_BAR;
        PG8_STAGE(PG8_SB(1, 0), cB + kstep, voffB); PG8_STAGE(PG8_SA(1, 0), cA + kstep, voffA); PG8_STAGE(PG8_SB(1, 1), cB + hstepB + kstep, voffB);
        PG8_WAIT_V(6); PG8_BAR;
    } else {
        PG8_STAGE(PG8_SB(0, 0), cB, voffB); PG8_STAGE(PG8_SA(0, 0), cA, voffA); PG8_STAGE(PG8_SB(0, 1), cB + hstepB, voffB); PG8_STAGE(PG8_SA(0, 1), cA + hstepA, voffA);
        if (wr == 1) PG8_BAR;
        PG8_WAIT_V(4); PG8_BAR;
        PG8_STAGE(PG8_SB(1, 0), cB + kstep, voffB); PG8_STAGE(PG8_SA(1, 0), cA + kstep, voffA); PG8_STAGE(PG8_SB(1, 1), cB + hstepB + kstep, voffB);
        PG8_WAIT_V(6); PG8_BAR;
    }
    for (;;) {
        const bool has_next = S.next(ui + 1, nxt);
        const char* nA = has_next ? (const char*)g.A + (size_t)nxt.pm * tstepA : cA; const char* nB = has_next ? (const char*)g.Bt + (size_t)nxt.pn * tstepB : cB;
        for (int t = 0; t < nt; t += 2) {
            const bool last = (t == nt - 2);
            const char* a1 = cA + (size_t)(t + 1) * kstep;
            const char* a2 = last ? nA : cA + (size_t)(t + 2) * kstep; const char* b2 = last ? nB : cB + (size_t)(t + 2) * kstep;
            const char* a3 = a2 + kstep; const char* b3 = b2 + kstep;
            if (last && has_next) S.a_ready(nxt);
            if constexpr (SP2) {
            PG8_LDB(B0, 0, 0); PG8_LDB(B1, 0, 1); PG8_SCHED; PG8_LDA(At, 0, 0); PG8_STAGE(PG8_SA(1, 1), a1 + hstepA, voffA);
            PG8_WAIT_V(8); PG8_WAIT_L(0); PG8_BAR; PG8_MMA(0, 0, At, B0); PG8_MMA(0, 1, At, B1); PG8_BAR; PG8_SCHED;
            PG8_LDA(At, 0, 1); PG8_STAGE(PG8_SB(0, 0), b2, voffB); PG8_STAGE(PG8_SB(0, 1), b2 + hstepB, voffB); PG8_STAGE(PG8_SA(0, 0), a2, voffA);
            PG8_WAIT_V(8); PG8_WAIT_L(0); PG8_BAR; PG8_MMA(1, 0, At, B0); PG8_MMA(1, 1, At, B1); PG8_BAR; PG8_SCHED;
            PG8_LDB(B0, 1, 0); PG8_LDB(B1, 1, 1); PG8_SCHED; PG8_LDA(At, 1, 0); PG8_STAGE(PG8_SA(0, 1), a2 + hstepA, voffA);
            PG8_WAIT_V(8); PG8_WAIT_L(0); PG8_BAR; PG8_MMA(0, 0, At, B0); PG8_MMA(0, 1, At, B1); PG8_BAR; PG8_SCHED;
            PG8_LDA(At, 1, 1); PG8_STAGE(PG8_SB(1, 0), b3, voffB); PG8_STAGE(PG8_SB(1, 1), b3 + hstepB, voffB); PG8_STAGE(PG8_SA(1, 0), a3, voffA);
            PG8_WAIT_V(8); PG8_WAIT_L(0); PG8_BAR; PG8_MMA(1, 0, At, B0); PG8_MMA(1, 1, At, B1); PG8_BAR; PG8_SCHED;
            } else {
            PG8_LDB(B0, 0, 0); PG8_SCHED; PG8_LDA(At, 0, 0); PG8_STAGE(PG8_SA(1, 1), a1 + hstepA, voffA);
            PG8_WAIT_L(8); PG8_BAR; PG8_WAIT_L(0); PG8_MMA(0, 0, At, B0); PG8_BAR; PG8_SCHED;
            PG8_LDB(B1, 0, 1); PG8_STAGE(PG8_SB(0, 0), b2, voffB);
            PG8_BAR; PG8_WAIT_L(0); PG8_MMA(0, 1, At, B1); PG8_BAR;
            PG8_LDA(At, 0, 1); PG8_STAGE(PG8_SA(0, 0), a2, voffA);
            PG8_BAR; PG8_WAIT_L(0); PG8_MMA(1, 0, At, B0); PG8_BAR; PG8_SCHED;
            PG8_STAGE(PG8_SB(0, 1), b2 + hstepB, voffB);
            PG8_WAIT_V(6); PG8_BAR; PG8_MMA(1, 1, At, B1); PG8_BAR;
            PG8_LDB(B0, 1, 0); PG8_SCHED; PG8_LDA(At, 1, 0); PG8_STAGE(PG8_SA(0, 1), a2 + hstepA, voffA);
            PG8_WAIT_L(8); PG8_BAR; PG8_WAIT_L(0); PG8_MMA(0, 0, At, B0); PG8_BAR; PG8_SCHED;
            PG8_LDB(B1, 1, 1); PG8_STAGE(PG8_SB(1, 0), b3, voffB);
            PG8_BAR; PG8_WAIT_L(0); PG8_MMA(0, 1, At, B1); PG8_BAR;
            PG8_LDA(At, 1, 1); PG8_STAGE(PG8_SA(1, 0), a3, voffA);
            PG8_BAR; PG8_WAIT_L(0); PG8_MMA(1, 0, At, B0); PG8_BAR; PG8_SCHED;
            PG8_STAGE(PG8_SB(1, 1), b3 + hstepB, voffB);
            PG8_WAIT_V(6); PG8_BAR; PG8_MMA(1, 1, At, B1); PG8_BAR;
            }
        }
        if constexpr (ALIGN_EPI) { if (wr == 0) PG8_BAR; }
        if constexpr (!Epi::AFTER_DRAIN) { E(acc, cur, wr, wc, fr, fq); S.done(cur); }
        if (!has_next) break;
#pragma unroll
        for (int a = 0; a < 2; ++a)
#pragma unroll
            for (int b = 0; b < 2; ++b)
#pragma unroll
                for (int m = 0; m < 4; ++m)
#pragma unroll
                    for (int n = 0; n < 2; ++n) acc[a][b][m][n] = (f32x4){0.f, 0.f, 0.f, 0.f};
        cur = nxt; cA = nA; cB = nB; ++ui;
        if constexpr (ALIGN_EPI) { if (wr == 1) PG8_BAR; }
    }
    PG8_WAIT_V(0);
    if constexpr (!ALIGN_EPI) { if (wr == 0) PG8_BAR; }
    PG8_BAR;
    if constexpr (Epi::AFTER_DRAIN) { E.fused(acc, cur, wr, wc, fr, fq, lds, wid, lane); S.done(cur); }
#undef PG8_SA
#undef PG8_SB
#undef PG8_STAGE
#undef PG8_LDA
#undef PG8_LDB
#undef PG8_MMA
#undef PG8_WAIT_V
#undef PG8_WAIT_L
#undef PG8_BAR
#undef PG8_SCHED
}
}

#define GAS __attribute__((address_space(1)))
#define LAS __attribute__((address_space(3)))
typedef unsigned short bf16_t;
typedef unsigned u32x4 __attribute__((ext_vector_type(4)));
typedef unsigned u32x2 __attribute__((ext_vector_type(2)));
typedef float f32x4 __attribute__((ext_vector_type(4)));
typedef short bf16x8 __attribute__((ext_vector_type(8)));
typedef short s16x4 __attribute__((ext_vector_type(4)));

constexpr int NB = 2, S = 8192, D = 1024, M = NB * S, FF = 4096;
constexpr int NIN = 7680;
constexpr float NORM_EPS = 1e-6f, GN_EPS = 64e-5f;
constexpr size_t MiB = 1u << 20;
constexpr size_t WS_MOD = 0;
constexpr size_t WS_CTL = 512 * 1024, CTL_BYTES = 49152;
constexpr size_t WS_XB1 = 3 * MiB, WS_XB2 = 5 * MiB;
constexpr size_t WS_ROPE = 1 * MiB;
constexpr size_t WS_LSE = 2 * MiB;
constexpr size_t WS_WIN = 3 * MiB;
constexpr size_t WS_WFF1 = 18 * MiB;
constexpr size_t WS_WFF2 = 26 * MiB;
constexpr size_t WS_WBR = 34 * MiB;
constexpr size_t WS_WOUT = 37 * MiB;
constexpr size_t WS_WL1 = 39 * MiB;
constexpr size_t WS_WL2 = 39 * MiB + 512 * 1024;
constexpr size_t WS_H = 40 * MiB;
constexpr size_t WS_QKV = 72 * MiB;
constexpr size_t WS_RKV = 144 * MiB;
constexpr size_t WS_LRAW = 240 * MiB;
constexpr size_t WS_LA = 248 * MiB;
constexpr size_t WS_END = 256 * MiB;
constexpr size_t WS_O = WS_H;
constexpr size_t WS_Y = WS_H;
constexpr size_t WS_LW = WS_QKV;
constexpr size_t WS_AA = WS_QKV + 32 * MiB;
constexpr size_t WS_GG = WS_QKV;
constexpr size_t WS_ORW = 72 * MiB;
constexpr size_t WS_OATT = WS_LRAW;
constexpr size_t WS_MRG = WS_RKV;
constexpr size_t WS_MERGED = WS_RKV + 64 * MiB;
constexpr size_t WS_MIX = WS_H;
constexpr size_t WS_H2 = 176 * MiB;
constexpr size_t WS_FFH = WS_H;
constexpr size_t WS_F = 168 * MiB;
constexpr size_t WS_G1P = 72 * MiB;
constexpr size_t WS_SPP = 104 * MiB;
constexpr size_t WS_WC = 136 * MiB;
constexpr int LDS_BYTES = 147456;

__device__ __forceinline__ float bf2f(unsigned v) { return __uint_as_float(v << 16); }
__device__ __forceinline__ unsigned f2bf(float f) { unsigned u = __float_as_uint(f); return (u + 0x7fffu + ((u >> 16) & 1u)) >> 16; }
typedef float f32x2_t __attribute__((ext_vector_type(2))); typedef __bf16 bf16x2_t __attribute__((ext_vector_type(2)));
__device__ __forceinline__ unsigned pk2(float lo, float hi) { const f32x2_t v = {lo, hi}; const bf16x2_t b = __builtin_convertvector(v, bf16x2_t); return __builtin_bit_cast(unsigned, b); }
__device__ __forceinline__ void unpack8(const u32x4 v, float* f) {
    f[0] = bf2f(v.x & 0xffffu); f[1] = __uint_as_float(v.x & 0xffff0000u); f[2] = bf2f(v.y & 0xffffu); f[3] = __uint_as_float(v.y & 0xffff0000u);
    f[4] = bf2f(v.z & 0xffffu); f[5] = __uint_as_float(v.z & 0xffff0000u); f[6] = bf2f(v.w & 0xffffu); f[7] = __uint_as_float(v.w & 0xffff0000u);
}
__device__ __forceinline__ u32x4 pack8(const float* f) { u32x4 o; o.x = pk2(f[0], f[1]); o.y = pk2(f[2], f[3]); o.z = pk2(f[4], f[5]); o.w = pk2(f[6], f[7]); return o; }
__device__ __forceinline__ float sigmoidf_(float x) { return __builtin_amdgcn_rcpf(1.0f + __expf(-x)); }
template <int CTRL> __device__ __forceinline__ float dppf(float v) { return __uint_as_float((unsigned)__builtin_amdgcn_update_dpp(0, (int)__float_as_uint(v), CTRL, 0xF, 0xF, true)); }
__device__ __forceinline__ float red8(float v) { v += dppf<0xB1>(v); v += dppf<0x4E>(v); v += dppf<0x141>(v); return v; }
__device__ __forceinline__ float red16(float v) { v = red8(v); v += dppf<0x140>(v); return v; }
__device__ __forceinline__ float wave_sum(float v) {
#pragma unroll
    for (int o = 1; o < 64; o <<= 1) v += __shfl_xor(v, o);
    return v;
}

struct Params { const float* in[25]; float* out; unsigned char* ws; };
typedef const Params __attribute__((address_space(4)))* CP;
__device__ __forceinline__ CP get_params() { CP q = (CP)__builtin_amdgcn_kernarg_segment_ptr(); asm volatile("" : "+s"(q)); return q; }
__device__ __forceinline__ int fresh_tid() { int t = threadIdx.x; asm volatile("" : "+v"(t)); return t; }

#define XB_TMO      128
#define XB_XCNT(j)  (256  + 64 * (j))
#define XB_XSUB(j)  (1280 + 64 * (j))
#define XB_XGEN(j)  (2304 + 64 * (j))
#define XB_TOP      3328
#define XB_TOPGEN   3392
#define XCD_BAR_WORDS 3456
#define XB_SPIN_CAP (1u << 18)

__device__ __forceinline__ unsigned xb_ld(unsigned* p)              { return __hip_atomic_load(p, __ATOMIC_RELAXED, __HIP_MEMORY_SCOPE_AGENT); }
__device__ __forceinline__ unsigned xb_add(unsigned* p, unsigned v) { return __hip_atomic_fetch_add(p, v, __ATOMIC_RELAXED, __HIP_MEMORY_SCOPE_AGENT); }
__device__ __forceinline__ unsigned xb_xcc_id() { return (unsigned)__builtin_amdgcn_s_getreg((3 << 11) | 20) & 0xFu; }
#define XB_SPIN(cond, bar) do { unsigned _sp = 0; while (cond) { __builtin_amdgcn_s_sleep(1); \
    if ((++_sp & 255u) == 0u) { if (xb_ld(&(bar)[XB_TMO])) break; if (_sp > XB_SPIN_CAP) { atomicAdd(&(bar)[XB_TMO], 1u); break; } } } } while (0)

struct XcdBarrier {
    unsigned* bar; unsigned x;
    volatile LAS unsigned* st;
};

__device__ __forceinline__ XcdBarrier xcd_barrier_post(unsigned* bar, volatile LAS unsigned* st) {
    XcdBarrier b; b.bar = bar; b.x = xb_xcc_id(); b.st = st;
    if (threadIdx.x == 0) (void)xb_add(&bar[XB_XCNT(b.x)], 1u);
    return b;
}
__device__ __forceinline__ void xcd_barrier_complete(unsigned* bar, unsigned x, unsigned& nloc, unsigned& nx) {
    const unsigned G = gridDim.x * gridDim.y * gridDim.z;
    unsigned sum, cnt, mine, sp = 0u;
    for (;;) {
        sum = 0u; cnt = 0u; mine = 0u;
#pragma unroll
        for (unsigned j = 0; j < 16; ++j) { const unsigned c = xb_ld(&bar[XB_XCNT(j)]); sum += c; cnt += (c > 0u) ? 1u : 0u; mine = (j == x) ? c : mine; }
        if (sum == G) break;
        __builtin_amdgcn_s_sleep(1);
        if ((++sp & 255u) == 0u) { if (xb_ld(&bar[XB_TMO])) break; if (sp > XB_SPIN_CAP) { atomicAdd(&bar[XB_TMO], 1u); break; } }
    }
    nloc = mine > 0u ? mine : 1u; nx = cnt > 0u ? cnt : 1u;
}

__device__ __forceinline__ void xcd_barrier(const XcdBarrier& b) {
    asm volatile("s_waitcnt vmcnt(0)" ::: "memory");
    __syncthreads();
    if (threadIdx.x == 0) {
        unsigned* bar = b.bar;
        __builtin_amdgcn_s_waitcnt(0);
        unsigned nloc = b.st[0], nx = b.st[1];
        if (nloc == 0u) { xcd_barrier_complete(bar, b.x, nloc, nx); b.st[0] = nloc; b.st[1] = nx; }
        const unsigned old = xb_add(&bar[XB_XSUB(b.x)], 1u);
        const unsigned gen = old / nloc;
        if (old + 1u == (gen + 1u) * nloc) {
            __builtin_amdgcn_fence(__ATOMIC_RELEASE, "agent");
            asm volatile("s_waitcnt vmcnt(0)" ::: "memory");
            const unsigned og = xb_add(&bar[XB_TOP], 1u);
            const unsigned tg = og / nx;
            if (og + 1u == (tg + 1u) * nx) xb_add(&bar[XB_TOPGEN], 1u);
            else XB_SPIN(xb_ld(&bar[XB_TOPGEN]) == tg, bar);
            __builtin_amdgcn_fence(__ATOMIC_ACQUIRE, "agent");
            xb_add(&bar[XB_XGEN(b.x)], 1u);
            asm volatile("s_waitcnt vmcnt(0)" ::: "memory");
        } else {
            XB_SPIN(xb_ld(&bar[XB_XGEN(b.x)]) == gen, bar);
            __builtin_amdgcn_fence(__ATOMIC_ACQUIRE, "agent");
            asm volatile("s_waitcnt vmcnt(0)" ::: "memory");
        }
    }
    __syncthreads();
}


__device__ __forceinline__ void st8bf(bf16_t* p, const f32x4 a, const f32x4 b) {
    u32x4 w; w.x = pk2(a[0], a[1]); w.y = pk2(a[2], a[3]); w.z = pk2(b[0], b[1]); w.w = pk2(b[2], b[3]); *(u32x4*)p = w;
}
struct FInProj { bf16_t *QKV, *RKV, *LRAW, *G;
    __device__ __forceinline__ void operator()(int row, int col, f32x4 a, f32x4 b) const {
        if (col < 2048) {
#pragma unroll
            for (int i = 0; i < 4; ++i) { a[i] = sigmoidf_(a[i]); b[i] = sigmoidf_(b[i]); }
            st8bf(G + (size_t)row * 2048 + col, a, b);
        }
        else if (col < 5120) { const int cr = col - 2048, sec = cr >> 10, hh = (cr >> 6) & 15, d = cr & 63;
            st8bf(RKV + ((size_t)((row >> 13) * 16 + hh) * S + (row & (S - 1))) * 192 + sec * 64 + d, a, b); }
        else if (col < 5376) st8bf(LRAW + (size_t)row * 256 + (col - 5120), a, b);
        else st8bf(QKV + (size_t)row * 2304 + (col - 5376), a, b);
    }
};
__device__ __forceinline__ float lwf(float z) { return -0.60653065971263342f * __builtin_amdgcn_rcpf(1.0f + __expf(-z)); }
struct FBf16 { bf16_t* O; int ldc;
    __device__ __forceinline__ void operator()(int row, int col, f32x4 a, f32x4 b) const { st8bf(O + (size_t)row * ldc + col, a, b); } };
struct FRelu2 { bf16_t* O; int ldc;
    __device__ __forceinline__ void operator()(int row, int col, f32x4 a, f32x4 b) const {
#pragma unroll
        for (int i = 0; i < 4; ++i) { float r = fmaxf(a[i], 0.f); a[i] = r * r; r = fmaxf(b[i], 0.f); b[i] = r * r; }
        st8bf(O + (size_t)row * ldc + col, a, b); } };
struct FM1 { const bf16_t* G; bf16_t* MRG;
    __device__ __forceinline__ void operator()(int row, int col, f32x4 a, f32x4 b) const {
        float g[8]; unpack8(*(const u32x4*)(G + (size_t)row * 2048 + col), g);
        a = (f32x4){a[0] * g[0], a[1] * g[1], a[2] * g[2], a[3] * g[3]}; b = (f32x4){b[0] * g[4], b[1] * g[5], b[2] * g[6], b[3] * g[7]};
        st8bf(MRG + (size_t)row * 1024 + col, a, b); } };
struct FM2 { const bf16_t* G; const bf16_t* MRG; bf16_t* O;
    __device__ __forceinline__ void operator()(int row, int col, f32x4 a, f32x4 b) const {
        float g[8], mr[8]; unpack8(*(const u32x4*)(G + (size_t)row * 2048 + 1024 + col), g); unpack8(*(const u32x4*)(MRG + (size_t)row * 1024 + col), mr);
        a = (f32x4){mr[0] + a[0] * g[0], mr[1] + a[1] * g[1], mr[2] + a[2] * g[2], mr[3] + a[3] * g[3]};
        b = (f32x4){mr[4] + b[0] * g[4], mr[5] + b[1] * g[5], mr[6] + b[2] * g[6], mr[7] + b[3] * g[7]};
        st8bf(O + (size_t)row * 1024 + col, a, b); } };

#define RLX_AGENT __ATOMIC_RELAXED, __HIP_MEMORY_SCOPE_AGENT
template <int NV> struct PanelX {
    unsigned long long* xbuf; unsigned* cnt;
    __device__ __forceinline__ void run(const pg8::Unit& u, LAS unsigned char* lds, int wid, int lane, float (&tot)[4]) const {
        LAS float* P = (LAS float*)lds; volatile LAS unsigned* flag = (volatile LAS unsigned*)(lds + 20480);
        asm volatile("s_waitcnt lgkmcnt(0)" ::: "memory"); __builtin_amdgcn_s_barrier(); asm volatile("" ::: "memory");
        const int row = wid * 32 + (lane & 31);
        if (lane < 32) {
            const f32x4 a = *(const LAS f32x4*)(P + (row * 4 + 0) * 4), b = *(const LAS f32x4*)(P + (row * 4 + 1) * 4), c = *(const LAS f32x4*)(P + (row * 4 + 2) * 4), d = *(const LAS f32x4*)(P + (row * 4 + 3) * 4);
            const f32x4 s = (a + b) + (c + d);
            unsigned long long* slot = xbuf + ((size_t)(u.pm * 256 + row) * 4 + u.pn) * NV;
            __hip_atomic_store(slot, ((unsigned long long)__float_as_uint(s[1]) << 32) | __float_as_uint(s[0]), RLX_AGENT);
            if (NV == 2) __hip_atomic_store(slot + 1, ((unsigned long long)__float_as_uint(s[3]) << 32) | __float_as_uint(s[2]), RLX_AGENT);
        }
        asm volatile("s_waitcnt vmcnt(0)" ::: "memory");
        if (lane == 0) __hip_atomic_fetch_add(cnt + 64 * u.pm, 1u, RLX_AGENT);
        if (wid == 0) {
            unsigned sp = 0u;
            for (;;) { if ((unsigned)__builtin_amdgcn_readfirstlane(__hip_atomic_load(cnt + 64 * u.pm, RLX_AGENT)) >= 32u) break; if (++sp > (1u << 22)) break; __builtin_amdgcn_s_sleep(2); }
            __builtin_amdgcn_fence(__ATOMIC_ACQUIRE, "agent");
            if (lane == 0) flag[0] = 1u;
        }
        asm volatile("s_waitcnt vmcnt(0) lgkmcnt(0)" ::: "memory"); __builtin_amdgcn_s_barrier(); asm volatile("" ::: "memory");
        tot[0] = tot[1] = tot[2] = tot[3] = 0.f;
        if (lane < 32) { const unsigned long long* slot = xbuf + (size_t)(u.pm * 256 + row) * 4 * NV;
#pragma unroll
            for (int t = 0; t < 4; ++t) { const unsigned long long w = __hip_atomic_load(slot + t * NV, RLX_AGENT); tot[0] += __uint_as_float((unsigned)w); tot[1] += __uint_as_float((unsigned)(w >> 32));
                if (NV == 2) { const unsigned long long w2 = __hip_atomic_load(slot + t * NV + 1, RLX_AGENT); tot[2] += __uint_as_float((unsigned)w2); tot[3] += __uint_as_float((unsigned)(w2 >> 32)); } } }
    }
};
struct EpiRow1 {
    static constexpr bool PERM = true, AFTER_DRAIN = true;
    const float* x; float* X1; bf16_t* H2; const float* MOD; const float* gpost; const float* gpre2; PanelX<2> px;
    __device__ __forceinline__ void fused(f32x4 (&acc)[2][2][4][2], const pg8::Unit& u, int wr, int wc, int fr, int fq, LAS unsigned char* lds, int wid, int lane) const {
        const int b = (u.pm * 256) >> 13; const float* gt1 = MOD + b * 6144 + 2048; const float* sh2 = MOD + b * 6144 + 3072; const float* sc2 = MOD + b * 6144 + 4096;
        LAS float* P = (LAS float*)lds; LAS float* Sx = (LAS float*)(lds + 16384);
        const int colb = u.pn * 256 + wc * 32 + 8 * fq;
        f32x4 gg[2][2];
#pragma unroll
        for (int bj = 0; bj < 2; ++bj)
#pragma unroll
            for (int n = 0; n < 2; ++n) gg[bj][n] = *(const f32x4*)(gt1 + colb + bj * 128 + 4 * n) * *(const f32x4*)(gpost + colb + bj * 128 + 4 * n);
#pragma unroll
        for (int ai = 0; ai < 2; ++ai)
#pragma unroll
            for (int m = 0; m < 4; ++m) { const int rl = ai * 128 + wr * 64 + m * 16 + fr; const float* xr = x + (size_t)(u.pm * 256 + rl) * 1024 + colb;
                float pA = 0.f, pB = 0.f, pC = 0.f, pD = 0.f;
#pragma unroll
                for (int bj = 0; bj < 2; ++bj)
#pragma unroll
                    for (int n = 0; n < 2; ++n) { const f32x4 xv = *(const f32x4*)(xr + bj * 128 + 4 * n), mv = acc[ai][bj][m][n], t = gg[bj][n] * mv;
                        pA += (mv[0] * mv[0] + mv[1] * mv[1]) + (mv[2] * mv[2] + mv[3] * mv[3]); pB += (xv[0] * xv[0] + xv[1] * xv[1]) + (xv[2] * xv[2] + xv[3] * xv[3]);
                        pC += (xv[0] * t[0] + xv[1] * t[1]) + (xv[2] * t[2] + xv[3] * t[3]); pD += (t[0] * t[0] + t[1] * t[1]) + (t[2] * t[2] + t[3] * t[3]); }
                pA += __shfl_xor(pA, 16); pA += __shfl_xor(pA, 32); pB += __shfl_xor(pB, 16); pB += __shfl_xor(pB, 32);
                pC += __shfl_xor(pC, 16); pC += __shfl_xor(pC, 32); pD += __shfl_xor(pD, 16); pD += __shfl_xor(pD, 32);
                if (fq == 0) *(LAS f32x4*)(P + (rl * 4 + wc) * 4) = (f32x4){pA, pB, pC, pD};
                asm volatile("" ::: "memory"); }
        float tot[4]; px.run(u, lds, wid, lane, tot);
        if (lane < 32) { const float rs = 1.0f / sqrtf(tot[0] * (1.f / 1024.f) + NORM_EPS); const float ss2 = tot[1] + 2.0f * rs * tot[2] + rs * rs * tot[3];
            const int row = wid * 32 + lane; Sx[row * 2] = rs; Sx[row * 2 + 1] = 1.0f / sqrtf(fmaxf(ss2, 0.f) * (1.f / 1024.f) + NORM_EPS); }
        asm volatile("s_waitcnt lgkmcnt(0)" ::: "memory"); __builtin_amdgcn_s_barrier(); asm volatile("" ::: "memory");
#pragma unroll
        for (int ai = 0; ai < 2; ++ai)
#pragma unroll
            for (int m = 0; m < 4; ++m) { const int rl = ai * 128 + wr * 64 + m * 16 + fr; const size_t off = (size_t)(u.pm * 256 + rl) * 1024 + colb;
                const float rs = Sx[rl * 2], rs2 = Sx[rl * 2 + 1];
#pragma unroll
                for (int bj = 0; bj < 2; ++bj) { f32x4 h[2];
#pragma unroll
                    for (int n = 0; n < 2; ++n) { const int cc = colb + bj * 128 + 4 * n; const f32x4 xv = *(const f32x4*)(x + off + bj * 128 + 4 * n); const f32x4 x1 = xv + gg[bj][n] * acc[ai][bj][m][n] * rs;
                        *(f32x4*)(X1 + off + bj * 128 + 4 * n) = x1; h[n] = x1 * rs2 * *(const f32x4*)(gpre2 + cc) * (*(const f32x4*)(sc2 + cc) + 1.0f) + *(const f32x4*)(sh2 + cc); }
                    st8bf(H2 + off + bj * 128, h[0], h[1]); }
                asm volatile("" ::: "memory"); }
    }
};
struct EpiRow2 {
    static constexpr bool PERM = true, AFTER_DRAIN = true;
    float* X1; const float* MOD; const float* gpost2; PanelX<1> px;
    __device__ __forceinline__ void fused(f32x4 (&acc)[2][2][4][2], const pg8::Unit& u, int wr, int wc, int fr, int fq, LAS unsigned char* lds, int wid, int lane) const {
        const int b = (u.pm * 256) >> 13; const float* gt2 = MOD + b * 6144 + 5120;
        LAS float* P = (LAS float*)lds; LAS float* Sx = (LAS float*)(lds + 16384);
        const int colb = u.pn * 256 + wc * 32 + 8 * fq;
#pragma unroll
        for (int ai = 0; ai < 2; ++ai)
#pragma unroll
            for (int m = 0; m < 4; ++m) { const int rl = ai * 128 + wr * 64 + m * 16 + fr; float pA = 0.f;
#pragma unroll
                for (int bj = 0; bj < 2; ++bj)
#pragma unroll
                    for (int n = 0; n < 2; ++n) { const f32x4 mv = acc[ai][bj][m][n]; pA += (mv[0] * mv[0] + mv[1] * mv[1]) + (mv[2] * mv[2] + mv[3] * mv[3]); }
                pA += __shfl_xor(pA, 16); pA += __shfl_xor(pA, 32);
                if (fq == 0) *(LAS f32x4*)(P + (rl * 4 + wc) * 4) = (f32x4){pA, 0.f, 0.f, 0.f}; }
        float tot[4]; px.run(u, lds, wid, lane, tot);
        if (lane < 32) Sx[wid * 32 + lane] = 1.0f / sqrtf(tot[0] * (1.f / 1024.f) + NORM_EPS);
        asm volatile("s_waitcnt lgkmcnt(0)" ::: "memory"); __builtin_amdgcn_s_barrier(); asm volatile("" ::: "memory");
#pragma unroll
        for (int ai = 0; ai < 2; ++ai)
#pragma unroll
            for (int m = 0; m < 4; ++m) { const int rl = ai * 128 + wr * 64 + m * 16 + fr; const size_t off = (size_t)(u.pm * 256 + rl) * 1024 + colb; const float rs = Sx[rl];
#pragma unroll
                for (int bj = 0; bj < 2; ++bj)
#pragma unroll
                    for (int n = 0; n < 2; ++n) { const int cc = colb + bj * 128 + 4 * n; float* pp = X1 + off + bj * 128 + 4 * n;
                        *(f32x4*)pp = *(const f32x4*)pp + *(const f32x4*)(gt2 + cc) * *(const f32x4*)(gpost2 + cc) * acc[ai][bj][m][n] * rs; }
                asm volatile("" ::: "memory"); }
    }
};
template <class E> __device__ __forceinline__ void run_gemm_fused(LAS unsigned char* lds, const bf16_t* A, int lda, const bf16_t* Bt, int ldb, int N, int K, const E& e) {
    asm volatile("" : "+s"(K));
    pg8::Gemm g{A, Bt, M, N, K, lda, ldb}; pg8::StaticOrder So; So.init(M, N, (int)gridDim.x, (int)blockIdx.x);
    pg8::gemm_phase<E, pg8::StaticOrder, false, true>(lds, g, So, e);
}

template <class F> __device__ __forceinline__ void run_gemm(LAS unsigned char* lds, const bf16_t* A, int lda, const bf16_t* Bt, int ldb, int N, int K, const F& f) {
    asm volatile("" : "+s"(K));
    pg8::Gemm g{A, Bt, M, N, K, lda, ldb}; pg8::StaticOrder So; So.init(M, N, (int)gridDim.x, (int)blockIdx.x);
    pg8::EpiG<F> E{f};
    pg8::gemm_phase<pg8::EpiG<F>, pg8::StaticOrder, true, true>(lds, g, So, E);
}

__device__ __forceinline__ int win_vcol(int pc) { return pc < 2304 ? pc + 5376 : (pc < 5632 ? pc - 256 : pc - 5632); }
template <bool VMAP = false> __device__ __forceinline__ void p0_transpose_item(const float* W, int K, int N, bf16_t* WT, LAS float* scr, int item, int lane) {
    const int nblk = N / 32, kb = item / nblk, nb = item % nblk, k0 = 64 * kb, n0 = 32 * nb, v0 = VMAP ? win_vcol(n0) : n0;
#pragma unroll 8
    for (int i = 0; i < 32; ++i) { const int kk = 2 * i + (lane >> 5); scr[kk * 33 + (lane & 31)] = W[(size_t)(k0 + kk) * N + n0 + (lane & 31)]; }
    asm volatile("s_waitcnt lgkmcnt(0)" ::: "memory");
    const int c = lane & 7;
#pragma unroll
    for (int j = 0; j < 4; ++j) { const int n = (lane >> 3) + 8 * j; const LAS float* s = scr + (8 * c) * 33 + n;
        u32x4 o; o.x = pk2(s[0 * 33], s[1 * 33]); o.y = pk2(s[2 * 33], s[3 * 33]); o.z = pk2(s[4 * 33], s[5 * 33]); o.w = pk2(s[6 * 33], s[7 * 33]);
        *(u32x4*)(WT + (size_t)(v0 + n) * K + k0 + 8 * c) = o; }
    asm volatile("s_waitcnt lgkmcnt(0)" ::: "memory");
}

__device__ __forceinline__ void phase0(CP p, LAS unsigned char* lds) {
    const int tid = fresh_tid(), lane = tid & 63, wave = tid >> 6;
    unsigned char* ws = p->ws;
    const int gw = blockIdx.x * 8 + wave, NGW = gridDim.x * 8;
    {
        LAS float* sc = (LAS float*)lds;
        LAS float* red = (LAS float*)(lds + 8192);
        const float* c = p->in[1]; const float* aw = p->in[3]; const float* ab = p->in[4];
        float* MOD = (float*)(ws + WS_MOD);
        for (int it = blockIdx.x; it < 192; it += gridDim.x) {
            for (int i = tid; i < 2048; i += 512) { const float v = c[i]; sc[i] = v / (1.0f + expf(-v)); }
            __syncthreads();
            const int jl = lane & 31, kp = lane >> 5, j = it * 32 + jl; float a0 = 0.f, a1 = 0.f;
#pragma unroll 8
            for (int k = wave * 128 + kp; k < wave * 128 + 128; k += 2) { const float w = aw[(size_t)k * 6144 + j]; a0 += sc[k] * w; a1 += sc[1024 + k] * w; }
            a0 += __shfl_xor(a0, 32); a1 += __shfl_xor(a1, 32);
            if (kp == 0) { red[(wave * 2 + 0) * 32 + jl] = a0; red[(wave * 2 + 1) * 32 + jl] = a1; }
            __syncthreads();
            if (wave == 0) { const int bsel = lane >> 5; float s2 = ab[j];
#pragma unroll
                for (int w = 0; w < 8; ++w) s2 += red[(w * 2 + bsel) * 32 + jl];
                MOD[bsel * 6144 + j] = s2; }
            __syncthreads();
        }
    }
    {
        const int* pos = (const int*)p->in[2]; float* R = (float*)(ws + WS_ROPE);
        const float inv[8] = {1.0f, 0.19392274474868576f, 0.03760603093086393f, 0.007292664737217109f, 0.001414213562373095f, 0.0002742481756762073f, 5.318295896944988e-05f, 1.031338537721246e-05f};
        if (blockIdx.x >= 192) for (int m = ((int)blockIdx.x - 192) * 512 + tid; m < M; m += ((int)gridDim.x - 192) * 512) { const float pf = (float)pos[m];
#pragma unroll
            for (int i = 0; i < 8; ++i) { float sn, cs; sincosf(pf * inv[i], &sn, &cs); R[(size_t)m * 16 + i] = cs; R[(size_t)m * 16 + 8 + i] = sn; } }
    }
    {
        bf16_t* WL1 = (bf16_t*)(ws + WS_WL1); bf16_t* WL2 = (bf16_t*)(ws + WS_WL2);
        const float* w2 = p->in[12]; const float* a2 = p->in[14]; const float* g2 = p->in[15];
        if (blockIdx.x >= 192) for (int i = ((int)blockIdx.x - 192) * 512 + tid; i < 2048 * 128; i += ((int)gridDim.x - 192) * 512) { const int n = i >> 7, k = i & 127; float v = 0.f;
            if (n < 1024) { if (k < 64) v = w2[k * 1024 + n]; } else { if (k >= 64) v = a2[(k - 64) * 1024 + (n - 1024)]; }
            WL1[i] = (bf16_t)f2bf(v); }
        if (blockIdx.x >= 192) for (int i = ((int)blockIdx.x - 192) * 512 + tid; i < 1024 * 128; i += ((int)gridDim.x - 192) * 512) { const int n = i >> 7, k = i & 127; WL2[i] = (bf16_t)f2bf(g2[k * 1024 + n]); }
    }
}
__device__ __forceinline__ void phase_wt(CP p, LAS unsigned char* lds, int part, int blk0) {
    const int tid = fresh_tid(), lane = tid & 63, wave = tid >> 6;
    unsigned char* ws = p->ws;
    const int gw = ((int)blockIdx.x - blk0) * 8 + wave, NGW = ((int)gridDim.x - blk0) * 8;
    LAS float* scr = (LAS float*)(lds + 16384 + wave * 8704);
    constexpr int I_IN = (1024 / 64) * (NIN / 32), I_F1 = (1024 / 64) * (4096 / 32), I_F2 = (4096 / 64) * (1024 / 32), I_BR = (1280 / 64) * (1024 / 32), I_OUT = (1024 / 64) * (1024 / 32);
    if (part == 0) { for (int it = gw; it < I_IN; it += NGW) p0_transpose_item<true>(p->in[9], 1024, NIN, (bf16_t*)(ws + WS_WIN), scr, it, lane); }
    else {
        constexpr int NIT = I_F1 + I_F2 + I_BR + I_OUT;
        for (int it = gw; it < NIT; it += NGW) {
            int r = it;
            if (r < I_F1) { p0_transpose_item(p->in[23], 1024, 4096, (bf16_t*)(ws + WS_WFF1), scr, r, lane); continue; } r -= I_F1;
            if (r < I_F2) { p0_transpose_item(p->in[24], 4096, 1024, (bf16_t*)(ws + WS_WFF2), scr, r, lane); continue; } r -= I_F2;
            if (r < I_BR) { p0_transpose_item(p->in[21], 1280, 1024, (bf16_t*)(ws + WS_WBR), scr, r, lane); continue; } r -= I_BR;
            p0_transpose_item(p->in[22], 1024, 1024, (bf16_t*)(ws + WS_WOUT), scr, r, lane);
        }
    }
}

__device__ __forceinline__ void phase_h(CP p) {
    const int tid_ = fresh_tid(), lane = tid_ & 63, wave = tid_ >> 6;
    const float* x = p->in[0]; const float* gpre = p->in[5]; const float* MOD = (const float*)(p->ws + WS_MOD); bf16_t* H = (bf16_t*)(p->ws + WS_H);
    for (int m = blockIdx.x * 8 + wave; m < M; m += gridDim.x * 8) {
        const int b = m >> 13; const float* sh = MOD + b * 6144; const float* sc = sh + 1024;
        const f32x4* xr = (const f32x4*)(x + (size_t)m * D) + lane; f32x4 v[4]; float s = 0.f;
#pragma unroll
        for (int j = 0; j < 4; ++j) { v[j] = xr[64 * j]; s += (v[j].x * v[j].x + v[j].y * v[j].y) + (v[j].z * v[j].z + v[j].w * v[j].w); }
        const float rs = 1.0f / sqrtf(wave_sum(s) * (1.f / D) + NORM_EPS);
        u32x2* o8 = (u32x2*)(H + (size_t)m * D) + lane;
#pragma unroll
        for (int j = 0; j < 4; ++j) { const int c = 4 * lane + 256 * j; const f32x4 g = *(const f32x4*)(gpre + c), a = *(const f32x4*)(sc + c), bsh = *(const f32x4*)(sh + c);
            f32x4 h = v[j] * rs * g * (1.0f + a) + bsh; u32x2 w; w.x = pk2(h.x, h.y); w.y = pk2(h.z, h.w); o8[64 * j] = w; }
    }
}

__device__ __forceinline__ bf16x8 load_rope(const bf16_t* hp, const float* rp, int q4) {
    if (q4 >= 2) return *(const bf16x8*)(hp + q4 * 8);
    float lo[8], hi[8]; unpack8(*(const u32x4*)hp, lo); unpack8(*(const u32x4*)(hp + 8), hi);
    float cs[8], sn[8]; *(f32x4*)cs = *(const f32x4*)rp; *(f32x4*)(cs + 4) = *(const f32x4*)(rp + 4); *(f32x4*)sn = *(const f32x4*)(rp + 8); *(f32x4*)(sn + 4) = *(const f32x4*)(rp + 12);
    float o[8];
#pragma unroll
    for (int e = 0; e < 8; ++e) o[e] = (q4 == 0) ? (lo[e] * cs[e] - hi[e] * sn[e]) : (lo[e] * sn[e] + hi[e] * cs[e]);
    const u32x4 w = pack8(o); return __builtin_bit_cast(bf16x8, w);
}

typedef short v4i16a_t __attribute__((ext_vector_type(4)));
struct AttnRegs { u32x4 k[4], v[4]; f32x4 rp[4]; };
__device__ __forceinline__ void attn_decode(int it, int& b, int& head, int& dil, int& r, int& n) {
    b = it / 768; const int rem = it % 768; head = rem >> 6; const int blk = rem & 63, g = head >> 2, dsh = 2 * g, nbr = 64 >> dsh; dil = 1 << dsh; r = blk / nbr; n = blk % nbr;
}
__device__ __forceinline__ void attn_issue(CP p, AttnRegs& R, int it) {
    int b, head, dil, r, n; attn_decode(it, b, head, dil, r, n);
    const int tid = fresh_tid(), j = tid >> 1, half = tid & 1, ik = (n - 1) * 128 + j;
    const bf16_t* QKV = (const bf16_t*)(p->ws + WS_QKV); const float* ROPE = (const float*)(p->ws + WS_ROPE);
    const u32x4 z = (u32x4){0u, 0u, 0u, 0u};
    if (ik >= 0) { const int t = ik * dil + r; const bf16_t* src = QKV + ((size_t)b * S + t) * 2304 + head * 64 + half * 32;
#pragma unroll
        for (int i = 0; i < 4; ++i) { R.k[i] = *(const u32x4*)(src + 768 + i * 8); R.v[i] = *(const u32x4*)(src + 1536 + i * 8); }
        if (half == 0) { const float* rp = ROPE + ((size_t)b * S + t) * 16;
#pragma unroll
            for (int i = 0; i < 4; ++i) R.rp[i] = *(const f32x4*)(rp + 4 * i); }
    } else {
#pragma unroll
        for (int i = 0; i < 4; ++i) { R.k[i] = z; R.v[i] = z; R.rp[i] = (f32x4){1.f, 1.f, 1.f, 1.f}; } }
}
__device__ __forceinline__ void attn_commit(AttnRegs& R, LAS bf16_t* Ks, LAS bf16_t* Vs) {
    constexpr int ALD = 72; const int tid = fresh_tid(), j = tid >> 1, half = tid & 1;
    if (half == 0) { float lo[8], hi[8], cs[8], sn[8], o1[8], o2[8]; unpack8(R.k[0], lo); unpack8(R.k[1], hi);
        *(f32x4*)cs = R.rp[0]; *(f32x4*)(cs + 4) = R.rp[1]; *(f32x4*)sn = R.rp[2]; *(f32x4*)(sn + 4) = R.rp[3];
#pragma unroll
        for (int e = 0; e < 8; ++e) { o1[e] = lo[e] * cs[e] - hi[e] * sn[e]; o2[e] = lo[e] * sn[e] + hi[e] * cs[e]; }
        R.k[0] = pack8(o1); R.k[1] = pack8(o2); }
#pragma unroll
    for (int i = 0; i < 4; ++i) { *(LAS u32x4*)(Ks + j * ALD + half * 32 + i * 8) = R.k[i]; *(LAS u32x4*)(Vs + j * ALD + half * 32 + i * 8) = R.v[i]; }
}
__device__ __forceinline__ void phase_attn(CP p, LAS unsigned char* lds) {
    const int tid = fresh_tid(), lane = tid & 63, wv = tid >> 6, ql = lane & 15, q4 = lane >> 4;
    constexpr int ALD = 72;
    LAS bf16_t* Ks = (LAS bf16_t*)lds; LAS bf16_t* Vs = Ks + 256 * ALD;
    const bf16_t* QKV = (const bf16_t*)(p->ws + WS_QKV); const float* ROPE = (const float*)(p->ws + WS_ROPE);
    bf16_t* O = (bf16_t*)(p->ws + WS_O); float* LSE = (float*)(p->ws + WS_LSE);
    AttnRegs R;
    if ((int)blockIdx.x < 1536) { attn_issue(p, R, blockIdx.x); attn_commit(R, Ks, Vs); }
    __syncthreads();
    for (int it = blockIdx.x; it < 1536; it += gridDim.x) {
        int b, head, dil, r, n; attn_decode(it, b, head, dil, r, n);
        const bool more = it + (int)gridDim.x < 1536;
        if (more) attn_issue(p, R, it + gridDim.x);
        const bf16_t* base = QKV + (size_t)b * S * 2304;
        const int q0 = wv * 16, kt0 = wv < 6 ? wv : 6;
        const int tq = (n * 128 + q0 + ql) * dil + r; const size_t mq = (size_t)b * S + tq;
        const bf16_t* qp = base + (size_t)tq * 2304 + head * 64;
        const bf16x8 qf0 = load_rope(qp, ROPE + mq * 16, q4), qf1 = *(const bf16x8*)(qp + 32 + q4 * 8);
        f32x4 sc[10];
#pragma unroll
        for (int i = 0; i < 10; ++i) { const LAS bf16_t* kp = Ks + ((kt0 + i) * 16 + ql) * ALD + q4 * 8;
            const bf16x8 kf0 = *(const LAS bf16x8*)kp, kf1 = *(const LAS bf16x8*)(kp + 32);
            f32x4 a = (f32x4){0.f, 0.f, 0.f, 0.f};
            a = __builtin_amdgcn_mfma_f32_16x16x32_bf16(kf0, qf0, a, 0, 0, 0); a = __builtin_amdgcn_mfma_f32_16x16x32_bf16(kf1, qf1, a, 0, 0, 0); sc[i] = a; }
        const int qq = q0 + ql; float mx = -1e30f;
#pragma unroll
        for (int i = 0; i < 10; ++i)
#pragma unroll
            for (int jj = 0; jj < 4; ++jj) { const int j = (kt0 + i) * 16 + q4 * 4 + jj, lag = qq + 128 - j; const bool ok = (lag >= 0) && (lag <= 128) && ((n - 1) * 128 + j >= 0);
                const float s = ok ? sc[i][jj] * 0.125f : -1e30f; sc[i][jj] = s; mx = fmaxf(mx, s); }
        mx = fmaxf(mx, __shfl_xor(mx, 16)); mx = fmaxf(mx, __shfl_xor(mx, 32));
        float l = 0.f;
#pragma unroll
        for (int i = 0; i < 10; ++i)
#pragma unroll
            for (int jj = 0; jj < 4; ++jj) { const float s = sc[i][jj]; const float e = (s > -1e29f) ? __expf(s - mx) : 0.f; sc[i][jj] = e; l += e; }
        l += __shfl_xor(l, 16); l += __shfl_xor(l, 32);
        const float rl = __builtin_amdgcn_rcpf(l);
        bf16x8 pb[5];
#pragma unroll
        for (int s2 = 0; s2 < 5; ++s2) { u32x4 w; w.x = pk2(sc[2 * s2][0], sc[2 * s2][1]); w.y = pk2(sc[2 * s2][2], sc[2 * s2][3]); w.z = pk2(sc[2 * s2 + 1][0], sc[2 * s2 + 1][1]); w.w = pk2(sc[2 * s2 + 1][2], sc[2 * s2 + 1][3]); pb[s2] = __builtin_bit_cast(bf16x8, w); }
        bf16_t* op = O + mq * 768 + head * 64 + q4 * 4;
#pragma unroll
        for (int dt = 0; dt < 4; ++dt) { f32x4 a = (f32x4){0.f, 0.f, 0.f, 0.f};
#pragma unroll
            for (int s2 = 0; s2 < 5; ++s2) {
                const LAS bf16_t* vp = Vs + ((kt0 + 2 * s2) * 16 + q4 * 4 + (ql >> 2)) * ALD + dt * 16 + (ql & 3) * 4;
                const v4i16a_t v0 = __builtin_amdgcn_ds_read_tr16_b64_v4i16((LAS v4i16a_t*)vp), v1 = __builtin_amdgcn_ds_read_tr16_b64_v4i16((LAS v4i16a_t*)(vp + 16 * ALD));
                const bf16x8 vf = (bf16x8){v0[0], v0[1], v0[2], v0[3], v1[0], v1[1], v1[2], v1[3]};
                a = __builtin_amdgcn_mfma_f32_16x16x32_bf16(vf, pb[s2], a, 0, 0, 0); }
            u32x2 w; w.x = pk2(a[0] * rl, a[1] * rl); w.y = pk2(a[2] * rl, a[3] * rl); *(u32x2*)(op + dt * 16) = w; }
        if (q4 == 0) LSE[mq * 12 + head] = mx + __logf(l);
        __syncthreads();
        if (more) attn_commit(R, Ks, Vs);
        __syncthreads();
    }
}

__device__ __forceinline__ void phase_prep(CP p) {
    const bf16_t* LRAW = (const bf16_t*)(p->ws + WS_LRAW); bf16_t* LA = (bf16_t*)(p->ws + WS_LA); const float* mu = p->in[10] + 3072;
    for (int idx = blockIdx.x * 512 + fresh_tid(); idx < M * 32; idx += gridDim.x * 512) {
        const int m = idx >> 5, c8 = (idx & 31) * 8, t = m & (S - 1);
        float cur[8], prv[8], o[8]; unpack8(*(const u32x4*)(LRAW + (size_t)m * 256 + c8), cur);
        if (t > 0) unpack8(*(const u32x4*)(LRAW + (size_t)(m - 1) * 256 + c8), prv); else {
#pragma unroll
            for (int e = 0; e < 8; ++e) prv[e] = 0.f; }
#pragma unroll
        for (int e = 0; e < 8; ++e) { const float u = cur[e] + (prv[e] - cur[e]) * mu[c8 + e]; o[e] = (c8 < 64) ? tanhf(u) : ((c8 < 128) ? u : sigmoidf_(u)); }
        *(u32x4*)(LA + (size_t)m * 256 + c8) = pack8(o);
    }
}

__device__ __forceinline__ void phase_combine(CP p, int blk0) {
    const bf16_t* O = (const bf16_t*)(p->ws + WS_O); const float* LSE = (const float*)(p->ws + WS_LSE); bf16_t* OATT = (bf16_t*)(p->ws + WS_OATT);
    for (int idx = ((int)blockIdx.x - blk0) * 512 + fresh_tid(); idx < M * 32; idx += ((int)gridDim.x - blk0) * 512) {
        const int m = idx >> 5, hh = (idx & 31) >> 3, d8 = (idx & 7) * 8;
        const float l0 = LSE[(size_t)m * 12 + hh], l1 = LSE[(size_t)m * 12 + 4 + hh], l2 = LSE[(size_t)m * 12 + 8 + hh];
        const float mx = fmaxf(l0, fmaxf(l1, l2)); float e0 = __expf(l0 - mx), e1 = __expf(l1 - mx), e2 = __expf(l2 - mx); const float inv = __builtin_amdgcn_rcpf(e0 + e1 + e2); e0 *= inv; e1 *= inv; e2 *= inv;
        float a[8], b[8], c[8], o[8];
        unpack8(*(const u32x4*)(O + (size_t)m * 768 + hh * 64 + d8), a); unpack8(*(const u32x4*)(O + (size_t)m * 768 + (4 + hh) * 64 + d8), b); unpack8(*(const u32x4*)(O + (size_t)m * 768 + (8 + hh) * 64 + d8), c);
#pragma unroll
        for (int e = 0; e < 8; ++e) o[e] = e0 * a[e] + e1 * b[e] + e2 * c[e];
        *(u32x4*)(OATT + (size_t)m * 256 + hh * 64 + d8) = pack8(o);
    }
}


constexpr int LD = 72, MATB = 64 * LD * 2;
constexpr int SC_CUM = 13 * MATB;
constexpr int SC_SEG = SC_CUM + 16384;
constexpr int SC_WC = SC_SEG + 2048;
constexpr int SC_BS = SC_WC + 256;
constexpr int SC_KC = SC_BS + 256;
constexpr int SC_END = SC_KC + 1536;
static_assert(SC_END <= LDS_BYTES, "scan LDS map");
#define SLOT(i) ((LAS bf16_t*)(lds + (i) * MATB))

typedef short v4i16_t __attribute__((ext_vector_type(4)));
__device__ __forceinline__ bf16x8 tr_frag(const LAS bf16_t* base, int l15) {
    const LAS bf16_t* a = base + (l15 >> 2) * LD + (l15 & 3) * 4;
    const v4i16_t lo = __builtin_amdgcn_ds_read_tr16_b64_v4i16((LAS v4i16_t*)a), hi = __builtin_amdgcn_ds_read_tr16_b64_v4i16((LAS v4i16_t*)(a + 4 * LD));
    return (bf16x8){lo[0], lo[1], lo[2], lo[3], hi[0], hi[1], hi[2], hi[3]};
}
template <bool XT, bool NN> __device__ __forceinline__ void mm_block(const LAS bf16_t* X, const LAS bf16_t* Y, int it0, int jt0, int l15, int q4, f32x4 (&acc)[2][2]) {
#pragma unroll
    for (int s = 0; s < 2; ++s) {
        bf16x8 xf[2], yf[2];
#pragma unroll
        for (int a = 0; a < 2; ++a) { if (!XT) xf[a] = *(const LAS bf16x8*)(X + ((it0 + a) * 16 + l15) * LD + s * 32 + q4 * 8); else xf[a] = tr_frag(X + (s * 32 + q4 * 8) * LD + (it0 + a) * 16, l15); }
#pragma unroll
        for (int c = 0; c < 2; ++c) { if (!NN) yf[c] = *(const LAS bf16x8*)(Y + ((jt0 + c) * 16 + l15) * LD + s * 32 + q4 * 8); else yf[c] = tr_frag(Y + (s * 32 + q4 * 8) * LD + (jt0 + c) * 16, l15); }
#pragma unroll
        for (int a = 0; a < 2; ++a)
#pragma unroll
            for (int c = 0; c < 2; ++c) acc[a][c] = __builtin_amdgcn_mfma_f32_16x16x32_bf16(yf[c], xf[a], acc[a][c], 0, 0, 0);
    }
}
template <bool XT, bool NN> __device__ __forceinline__ void mm_row(const LAS bf16_t* X, const LAS bf16_t* Y, int it, int jt0, int l15, int q4, f32x4 (&acc)[2]) {
#pragma unroll
    for (int s = 0; s < 2; ++s) {
        bf16x8 xf, yf[2];
        if (!XT) xf = *(const LAS bf16x8*)(X + (it * 16 + l15) * LD + s * 32 + q4 * 8); else xf = tr_frag(X + (s * 32 + q4 * 8) * LD + it * 16, l15);
#pragma unroll
        for (int c = 0; c < 2; ++c) { if (!NN) yf[c] = *(const LAS bf16x8*)(Y + ((jt0 + c) * 16 + l15) * LD + s * 32 + q4 * 8); else yf[c] = tr_frag(Y + (s * 32 + q4 * 8) * LD + (jt0 + c) * 16, l15); }
#pragma unroll
        for (int c = 0; c < 2; ++c) acc[c] = __builtin_amdgcn_mfma_f32_16x16x32_bf16(yf[c], xf, acc[c], 0, 0, 0);
    }
}
template <bool XT, bool NN> __device__ __forceinline__ void mm_block_1s(const LAS bf16_t* X, const LAS bf16_t* Y, int it0, int jt0, int s, int l15, int q4, f32x4 (&acc)[2][2]) {
    bf16x8 xf[2], yf[2];
#pragma unroll
    for (int a = 0; a < 2; ++a) { if (!XT) xf[a] = *(const LAS bf16x8*)(X + ((it0 + a) * 16 + l15) * LD + s * 32 + q4 * 8); else xf[a] = tr_frag(X + (s * 32 + q4 * 8) * LD + (it0 + a) * 16, l15); }
#pragma unroll
    for (int c = 0; c < 2; ++c) { if (!NN) yf[c] = *(const LAS bf16x8*)(Y + ((jt0 + c) * 16 + l15) * LD + s * 32 + q4 * 8); else yf[c] = tr_frag(Y + (s * 32 + q4 * 8) * LD + (jt0 + c) * 16, l15); }
#pragma unroll
    for (int a = 0; a < 2; ++a)
#pragma unroll
        for (int c = 0; c < 2; ++c) acc[a][c] = __builtin_amdgcn_mfma_f32_16x16x32_bf16(yf[c], xf[a], acc[a][c], 0, 0, 0);
}
template <bool XT, bool NN> __device__ __forceinline__ void mm_row_1s(const LAS bf16_t* X, const LAS bf16_t* Y, int it, int jt0, int s, int l15, int q4, f32x4 (&acc)[2]) {
    bf16x8 xf, yf[2];
    if (!XT) xf = *(const LAS bf16x8*)(X + (it * 16 + l15) * LD + s * 32 + q4 * 8); else xf = tr_frag(X + (s * 32 + q4 * 8) * LD + it * 16, l15);
#pragma unroll
    for (int c = 0; c < 2; ++c) { if (!NN) yf[c] = *(const LAS bf16x8*)(Y + ((jt0 + c) * 16 + l15) * LD + s * 32 + q4 * 8); else yf[c] = tr_frag(Y + (s * 32 + q4 * 8) * LD + (jt0 + c) * 16, l15); }
#pragma unroll
    for (int c = 0; c < 2; ++c) acc[c] = __builtin_amdgcn_mfma_f32_16x16x32_bf16(yf[c], xf, acc[c], 0, 0, 0);
}
#define TRI_MM(XS, YS, INIT, STORE) do { const int role_ = wv & 3; \
    if (role_ == 0 || role_ == 3) { const int it0 = role_ ? 2 : 0, jtb = it0; f32x4 acc[2][2]; FOR_AC { BLK_IJ; acc[a][c] = INIT(i, j0); } \
        mm_block_1s<false, true>(XS, YS, it0, jtb, role_ ? 1 : 0, l15, q4, acc); FOR_AC { BLK_IJ; STORE(i, j0, acc[a][c]); } } \
    else { const int itr_ = role_ - 1; f32x4 acc[2]; _Pragma("unroll") for (int c = 0; c < 2; ++c) { const int i = itr_ * 16 + l15, j0 = (2 + c) * 16 + q4 * 4; acc[c] = INIT(i, j0); } \
        mm_row<false, true>(XS, YS, itr_, 2, l15, q4, acc); _Pragma("unroll") for (int c = 0; c < 2; ++c) { const int i = itr_ * 16 + l15, j0 = (2 + c) * 16 + q4 * 4; STORE(i, j0, acc[c]); } } } while (0)
#define INIT_ZERO(i, j0) ZERO4
#define FOR_AC _Pragma("unroll") for (int a = 0; a < 2; ++a) _Pragma("unroll") for (int c = 0; c < 2; ++c)
#define BLK_IJ const int i = (it0 + a) * 16 + l15, j0 = (jtb + c) * 16 + q4 * 4
__device__ __forceinline__ void st4bf(LAS bf16_t* p, const f32x4 a) { u32x2 w; w.x = pk2(a[0], a[1]); w.y = pk2(a[2], a[3]); *(LAS u32x2*)p = w; }
__device__ __forceinline__ f32x4 ld4bf(const LAS bf16_t* p) { const u32x2 w = *(const LAS u32x2*)p; return (f32x4){bf2f(w.x & 0xffffu), __uint_as_float(w.x & 0xffff0000u), bf2f(w.y & 0xffffu), __uint_as_float(w.y & 0xffff0000u)}; }
#define ZERO4 ((f32x4){0.f, 0.f, 0.f, 0.f})

struct ScanConst { int unused; };
struct ScanLoads { u32x4 xdw, xda, r0, k0, v0, r1, k1, v1; };
__device__ __forceinline__ void scan_issue(CP p, ScanLoads& L, int b, int h, int c) {
    const int tid = fresh_tid(), tt = tid >> 3, c8 = (tid & 7) * 8, ch = h * 64 + c8;
    const bf16_t* RKV = (const bf16_t*)(p->ws + WS_RKV); const bf16_t* LA = (const bf16_t*)(p->ws + WS_LA);
    const size_t m = (size_t)b * S + c * 64 + tt; const bool hasp = (c * 64 + tt) > 0; const u32x4 z = (u32x4){0u, 0u, 0u, 0u};
    L.xdw = *(const u32x4*)(LA + m * 256 + c8); L.xda = *(const u32x4*)(LA + m * 256 + 64 + c8);
    const bf16_t* rk = RKV + ((size_t)(b * 16 + h) * S + c * 64 + tt) * 192 + c8;
    L.r0 = *(const u32x4*)(rk); L.k0 = *(const u32x4*)(rk + 64); L.v0 = *(const u32x4*)(rk + 128);
    L.r1 = hasp ? *(const u32x4*)(rk - 192) : z; L.k1 = hasp ? *(const u32x4*)(rk - 128) : z; L.v1 = hasp ? *(const u32x4*)(rk - 64) : z;
}
__device__ __forceinline__ void scan_consts(CP p, LAS unsigned char* lds, ScanConst& K, int h) {
    const int tid = fresh_tid(), tt = tid >> 3, c8 = (tid & 7) * 8;
    const float* mu = p->in[10]; const float* k_k = p->in[16]; const float* k_a = p->in[17]; const float* r_k = p->in[18]; const bf16_t* WL1 = (const bf16_t*)(p->ws + WS_WL1);
    LAS float* KC = (LAS float*)(lds + SC_KC);
    if (tid < 64) { const int ch = h * 64 + tid; KC[tid] = mu[ch]; KC[64 + tid] = mu[1024 + ch]; KC[128 + tid] = mu[2048 + ch]; KC[192 + tid] = k_k[ch]; KC[256 + tid] = k_a[ch]; KC[320 + tid] = r_k[ch]; }
    *(LAS u32x4*)(SLOT(4) + tt * LD + c8) = *(const u32x4*)(WL1 + (size_t)(h * 64 + tt) * 128 + c8);
    *(LAS u32x4*)(SLOT(5) + tt * LD + c8) = *(const u32x4*)(WL1 + (size_t)(1024 + h * 64 + tt) * 128 + 64 + c8);
    (void)K;
}
__device__ __forceinline__ void scan_stage_x(LAS unsigned char* lds, const ScanLoads& L) { const int tid = fresh_tid(), tt = tid >> 3, c8 = (tid & 7) * 8;
    *(LAS u32x4*)(SLOT(7) + tt * LD + c8) = L.xdw; *(LAS u32x4*)(SLOT(9) + tt * LD + c8) = L.xda; }
__device__ __forceinline__ bf16_t* tm_blob(unsigned char* ws, int item) {
    constexpr int N0 = 2560, N1 = 1194;
    if (item < N0) return (bf16_t*)(ws + WS_WIN) + (size_t)item * 3072;
    if (item < N0 + N1) return (bf16_t*)(ws + 137 * MiB) + (size_t)(item - N0) * 3072;
    return (bf16_t*)(ws + 64 * MiB) + (size_t)(item - N0 - N1) * 3072;
}
__device__ __forceinline__ void tm_piece(int tid, int& blob_off, int& lds_off) {
    if (tid < 256) { const int r = tid >> 3, c = (tid & 7) * 8; blob_off = tid * 8; lds_off = r * LD + c; }
    else { const int t2 = tid - 256, r = 32 + (t2 >> 2), c = 32 + (t2 & 3) * 8; blob_off = 2048 + t2 * 8; lds_off = r * LD + c; }
}
template <int PASS> __device__ __forceinline__ void scan_front(CP p, LAS unsigned char* lds, const ScanConst& K, ScanLoads& L, int b, int h, int cn, int item, u32x2 sc0 = (u32x2){0u, 0u}, u32x2 sc1 = (u32x2){0u, 0u}, u32x4 tmv = (u32x4){0u, 0u, 0u, 0u}) {
    const int tid = fresh_tid(), lane = tid & 63, wv = tid >> 6, l15 = lane & 15, q4 = lane >> 4, it = wv >> 1, jt0 = (wv & 1) * 2;
    const int half = wv >> 2, it0 = ((wv & 3) >> 1) * 2, jtb = (wv & 1) * 2;
    const float* w0 = p->in[11]; const float* a0 = p->in[13];
    LAS float* CUM = (LAS float*)(lds + SC_CUM); LAS float* SEG = (LAS float*)(lds + SC_SEG); LAS float* WCl = (LAS float*)(lds + SC_WC); LAS float* BS = (LAS float*)(lds + SC_BS);
    const int tt = tid >> 3, c8 = (tid & 7) * 8;
    float rc[8], rp[8], kc[8], kp[8], vc[8], vp[8];
    unpack8(L.r0, rc); unpack8(L.k0, kc); unpack8(L.v0, vc); unpack8(L.r1, rp); unpack8(L.k1, kp); unpack8(L.v1, vp);
    { f32x4 acc[2][2] = {{ZERO4, ZERO4}, {ZERO4, ZERO4}};
      if (half == 0) { mm_block<false, false>(SLOT(7), SLOT(4), it0, jtb, l15, q4, acc);
          FOR_AC { BLK_IJ; const f32x4 wb = *(const f32x4*)(w0 + h * 64 + j0); const f32x4 v = acc[a][c];
              *(LAS f32x4*)(CUM + i * 64 + j0) = (f32x4){lwf(wb[0] + v[0]), lwf(wb[1] + v[1]), lwf(wb[2] + v[2]), lwf(wb[3] + v[3])}; } }
      else { mm_block<false, false>(SLOT(9), SLOT(5), it0, jtb, l15, q4, acc);
          FOR_AC { BLK_IJ; const f32x4 ab = *(const f32x4*)(a0 + h * 64 + j0); const f32x4 v = acc[a][c];
              st4bf(SLOT(3) + i * LD + j0, (f32x4){sigmoidf_(ab[0] + v[0]), sigmoidf_(ab[1] + v[1]), sigmoidf_(ab[2] + v[2]), sigmoidf_(ab[3] + v[3])}); } } }
    __syncthreads();
    { const int cc = tid & 63, sg = tid >> 6; float run = 0.f;
#pragma unroll
      for (int e = 0; e < 8; ++e) { run += CUM[(sg * 8 + e) * 64 + cc]; CUM[(sg * 8 + e) * 64 + cc] = run; }
      SEG[sg * 64 + cc] = run; }
    __syncthreads();
    {
        float av[8], cu[8], cpv[8];
        { const f32x4 a_lo = ld4bf(SLOT(3) + tt * LD + c8), a_hi = ld4bf(SLOT(3) + tt * LD + c8 + 4);
          *(f32x4*)av = a_lo; *(f32x4*)(av + 4) = a_hi;
          float off[8];
#pragma unroll
          for (int e = 0; e < 8; ++e) off[e] = 0.f;
          for (int s2 = 0; s2 < wv; ++s2) { const f32x4 o0 = *(const LAS f32x4*)(SEG + s2 * 64 + c8), o1 = *(const LAS f32x4*)(SEG + s2 * 64 + c8 + 4);
#pragma unroll
              for (int e = 0; e < 4; ++e) { off[e] += o0[e]; off[4 + e] += o1[e]; } }
          *(f32x4*)cu = *(const LAS f32x4*)(CUM + tt * 64 + c8); *(f32x4*)(cu + 4) = *(const LAS f32x4*)(CUM + tt * 64 + c8 + 4);
          if (tt & 7) { *(f32x4*)cpv = *(const LAS f32x4*)(CUM + (tt - 1) * 64 + c8); *(f32x4*)(cpv + 4) = *(const LAS f32x4*)(CUM + (tt - 1) * 64 + c8 + 4); }
          else {
#pragma unroll
              for (int e = 0; e < 8; ++e) cpv[e] = 0.f; }
#pragma unroll
          for (int e = 0; e < 8; ++e) { cu[e] += off[e]; cpv[e] += off[e]; } }
        const LAS float* KC = (const LAS float*)(lds + SC_KC) + c8;
#define KCV(a, e) KC[(a) * 64 + (e)]
        float rr[8], ks[8], vs[8], kk[8], ss = 0.f;
#pragma unroll
        for (int e = 0; e < 8; ++e) { rr[e] = rc[e] + (rp[e] - rc[e]) * KCV(0, e); ks[e] = kc[e] + (kp[e] - kc[e]) * KCV(1, e); vs[e] = vc[e] + (vp[e] - vc[e]) * KCV(2, e);
            kk[e] = ks[e] * KCV(3, e); ss += kk[e] * kk[e]; }
        ss = red8(ss); const float rn = __builtin_amdgcn_rsqf(fmaxf(ss, 1e-24f));
        float o_a[8], o_b[8], o_k[8], o_r[8], bsum = 0.f;
#pragma unroll
        for (int e = 0; e < 8; ++e) { const float kn = kk[e] * rn, km = ks[e] * (1.0f + (av[e] - 1.0f) * KCV(4, e));
            const float wi = __expf(cu[e]), we = __expf(cpv[e]), rwi = __builtin_amdgcn_rcpf(wi);
            o_a[e] = -kn * we; o_b[e] = kn * av[e] * rwi; o_k[e] = km * rwi; o_r[e] = rr[e] * wi; bsum += rr[e] * km * KCV(5, e);
            if (tt == 63) WCl[c8 + e] = wi; }
        *(LAS u32x4*)(SLOT(0) + tt * LD + c8) = pack8(o_a); *(LAS u32x4*)(SLOT(1) + tt * LD + c8) = pack8(o_b); *(LAS u32x4*)(SLOT(2) + tt * LD + c8) = pack8(o_k);
        if (PASS == 3) { *(LAS u32x4*)(SLOT(3) + tt * LD + c8) = pack8(o_r); bsum = red8(bsum); if ((tid & 7) == 0) BS[tt] = bsum; }
        *(LAS u32x4*)(SLOT(6) + tt * LD + c8) = pack8(vs);
    }
    if (cn >= 0) scan_issue(p, L, b, h, cn);
    __syncthreads();
    if (PASS == 1) {
    { f32x4 acc[2][2] = {{ZERO4, ZERO4}, {ZERO4, ZERO4}};
      if (half == 0) { mm_block<false, false>(SLOT(1), SLOT(0), it0, jtb, l15, q4, acc);
          FOR_AC { BLK_IJ; f32x4 v = acc[a][c], t0;
#pragma unroll
              for (int e = 0; e < 4; ++e) { v[e] = (i < j0 + e) ? v[e] : 0.f; t0[e] = (i == j0 + e) ? 1.0f : v[e]; }
              st4bf(SLOT(7) + i * LD + j0, v); st4bf(SLOT(10) + i * LD + j0, t0); } }
      else { mm_block<false, false>(SLOT(2), SLOT(0), it0, jtb, l15, q4, acc);
          FOR_AC { BLK_IJ; f32x4 v = acc[a][c];
#pragma unroll
              for (int e = 0; e < 4; ++e) v[e] = (i < j0 + e) ? v[e] : 0.f;
              st4bf(SLOT(12) + i * LD + j0, v); } } }
    __syncthreads();
    if (half == 0) {
#define STORE_N1(i, j0, v) st4bf(SLOT(8) + (i) * LD + (j0), v)
        TRI_MM(SLOT(7), SLOT(7), INIT_ZERO, STORE_N1); }
    __syncthreads();
#define NEU_STEP3(TSRC, TDST, NCUR, NNEXT) do { \
        if (half == 0) { TRI_MM(SLOT(TSRC), SLOT(NCUR), [&](int i_, int j_) { return ld4bf(SLOT(TSRC) + i_ * LD + j_); }, [&](int i_, int j_, f32x4 v_) { st4bf(SLOT(TDST) + i_ * LD + j_, v_); }); } \
        else { TRI_MM(SLOT(NCUR), SLOT(NCUR), INIT_ZERO, [&](int i_, int j_, f32x4 v_) { st4bf(SLOT(NNEXT) + i_ * LD + j_, v_); }); } \
        __syncthreads(); } while (0)
    NEU_STEP3(10, 11, 8, 9);
    NEU_STEP3(11, 10, 9, 8);
    NEU_STEP3(10, 11, 8, 9);
    NEU_STEP3(11, 10, 9, 8);
    if (half == 0) { TRI_MM(SLOT(10), SLOT(8), [&](int i_, int j_) { return ld4bf(SLOT(10) + i_ * LD + j_); }, [&](int i_, int j_, f32x4 v_) { st4bf(SLOT(11) + i_ * LD + j_, v_); }); }
    __syncthreads();
    if (tid < 384) { int bo, lo; tm_piece(tid, bo, lo); *(u32x4*)(tm_blob(p->ws, item) + bo) = *(const LAS u32x4*)(SLOT(11) + lo); }
    } else {
    if (half != 0) { f32x4 acc[2][2] = {{ZERO4, ZERO4}, {ZERO4, ZERO4}}; mm_block<false, false>(SLOT(2), SLOT(0), it0, jtb, l15, q4, acc);
        FOR_AC { BLK_IJ; f32x4 v = acc[a][c];
#pragma unroll
            for (int e = 0; e < 4; ++e) v[e] = (i < j0 + e) ? v[e] : 0.f;
            st4bf(SLOT(12) + i * LD + j0, v); } }
    if (tid < 384) { int bo, lo; tm_piece(tid, bo, lo); *(LAS u32x4*)(SLOT(11) + lo) = tmv; }
    __syncthreads();
    }
    { if (half == 0) { f32x4 acc[2][2] = {{ZERO4, ZERO4}, {ZERO4, ZERO4}};
          if (jtb == 0) mm_block_1s<true, true>(SLOT(0), SLOT(11), it0, jtb, 0, l15, q4, acc); else mm_block<true, true>(SLOT(0), SLOT(11), it0, jtb, l15, q4, acc);
          FOR_AC { BLK_IJ; st4bf(SLOT(7) + i * LD + j0, acc[a][c]); }
          if (PASS == 3) { FOR_AC { acc[a][c] = ZERO4; } mm_block<false, false>(SLOT(1), SLOT(3), it0, jtb, l15, q4, acc);
              FOR_AC { BLK_IJ; f32x4 v = acc[a][c];
#pragma unroll
                  for (int e = 0; e < 4; ++e) v[e] = (i <= j0 + e) ? v[e] : 0.f;
                  st4bf((LAS bf16_t*)(lds + SC_CUM) + i * LD + j0, v); } } }
      else { TRI_MM(SLOT(12), SLOT(11), INIT_ZERO, [&](int i_, int j_, f32x4 v_) { st4bf(SLOT(9) + i_ * LD + j_, v_); });
          if (PASS == 3) { f32x4 acc[2][2] = {{ZERO4, ZERO4}, {ZERO4, ZERO4}}; mm_block<false, false>(SLOT(2), SLOT(3), it0, jtb, l15, q4, acc);
              FOR_AC { BLK_IJ; f32x4 v = acc[a][c];
#pragma unroll
                  for (int e = 0; e < 4; ++e) v[e] = (i <= j0 + e) ? v[e] : 0.f;
                  st4bf(SLOT(8) + i * LD + j0, v); } } } }
    if (PASS == 3) {
        const int vbmt = tid >> 6; *(LAS u32x2*)(SLOT(10) + ((vbmt >> 2) * 16 + (lane & 15)) * LD + (vbmt & 3) * 16 + (lane >> 4) * 4) = sc0;
        const int vbmt1 = vbmt + 8; *(LAS u32x2*)(SLOT(10) + ((vbmt1 >> 2) * 16 + (lane & 15)) * LD + (vbmt1 & 3) * 16 + (lane >> 4) * 4) = sc1; }
    __syncthreads();
}

__device__ __forceinline__ void phase_scanA(CP p, LAS unsigned char* lds) {
    const int tid = fresh_tid(), lane = tid & 63, wv = tid >> 6, l15 = lane & 15, q4 = lane >> 4, it = wv >> 1, jt0 = (wv & 1) * 2;
    bf16_t* G1P = (bf16_t*)(p->ws + WS_G1P); bf16_t* SPP = (bf16_t*)(p->ws + WS_SPP); float* WC = (float*)(p->ws + WS_WC);
    LAS float* WCl = (LAS float*)(lds + SC_WC);
    const int bh = blockIdx.x >> 3, b = bh >> 4, h = bh & 15, cb = blockIdx.x & 7;
    ScanConst K; ScanLoads L;
    scan_consts(p, lds, K, h); scan_issue(p, L, b, h, cb); scan_stage_x(lds, L); __syncthreads();
    for (int i = 0; i < 16; ++i) {
        const int c = cb + 8 * i, item = bh * 128 + c;
        scan_front<1>(p, lds, K, L, b, h, i < 15 ? c + 8 : -1, item);
        if (tid < 64) WC[(size_t)item * 64 + tid] = WCl[tid];
        { const int half = wv >> 2, it0 = ((wv & 3) >> 1) * 2, jtb = (wv & 1) * 2; f32x4 acc[2][2];
          if (half == 0) { FOR_AC { acc[a][c] = ZERO4; } mm_block<true, false>(SLOT(1), SLOT(7), it0, jtb, l15, q4, acc);
              FOR_AC { const int itt = it0 + a, jt = jtb + c; const float wi = WCl[itt * 16 + l15]; const f32x4 v = acc[a][c];
                  u32x2 w; w.x = pk2(v[0] * wi, v[1] * wi); w.y = pk2(v[2] * wi, v[3] * wi);
                  *(u32x2*)(G1P + (size_t)item * 4096 + ((itt * 2 + (jt >> 1)) * 64 + lane) * 8 + (jt & 1) * 4) = w; } }
          else { FOR_AC { BLK_IJ; acc[a][c] = ld4bf(SLOT(2) + i * LD + j0); }
              if (it0 == 2) mm_block_1s<false, true>(SLOT(9), SLOT(1), it0, jtb, 1, l15, q4, acc); else mm_block<false, true>(SLOT(9), SLOT(1), it0, jtb, l15, q4, acc);
              FOR_AC { BLK_IJ; st4bf(SLOT(10) + i * LD + j0, acc[a][c]); } } }
        __syncthreads();
        { f32x4 acc[2] = {ZERO4, ZERO4}; mm_row<true, true>(SLOT(6), SLOT(10), it, jt0, l15, q4, acc);
#pragma unroll
          for (int c = 0; c < 2; ++c) { const int jt = jt0 + c, j0 = jt * 16 + q4 * 4; const f32x4 wc4 = *(const LAS f32x4*)(WCl + j0); const f32x4 v = acc[c];
              u32x2 w; w.x = pk2(v[0] * wc4[0], v[1] * wc4[1]); w.y = pk2(v[2] * wc4[2], v[3] * wc4[3]);
              *(u32x2*)(SPP + (size_t)item * 4096 + ((it * 4 + jt) * 64 + lane) * 4) = w; } }
        if (i < 15) scan_stage_x(lds, L);
        __syncthreads();
    }
}

template <bool DRY> __device__ __forceinline__ void phase_scanB(CP p, LAS unsigned char* lds) {
    if (blockIdx.x >= 32) return;
    const int tid = fresh_tid(), lane = tid & 63, wv = tid >> 6, q4 = lane >> 4;
    const bf16_t* G1P = (const bf16_t*)(p->ws + WS_G1P); bf16_t* SPP = (bf16_t*)(p->ws + WS_SPP); const float* WC = (const float*)(p->ws + WS_WC);
    const int bh = blockIdx.x, vb = wv;
    constexpr int CB = 16640, HB = 4 * CB;
    static_assert(2 * HB <= LDS_BYTES, "pass B LDS");
    u32x4 g[4], s[4]; f32x4 wreg = ZERO4;
#define SB_ISSUE(r) do { _Pragma("unroll") for (int ci = 0; ci < 4; ++ci) { const size_t item = (size_t)bh * 128 + (r) * 4 + ci; g[ci] = *(const u32x4*)(G1P + item * 4096 + tid * 8); s[ci] = *(const u32x4*)(SPP + item * 4096 + tid * 8); } \
        if (tid < 64) wreg = *(const f32x4*)(WC + ((size_t)bh * 128 + (r) * 4 + (tid >> 4)) * 64 + (tid & 15) * 4); } while (0)
#define SB_COMMIT(hf) do { LAS unsigned char* base = lds + (hf) * HB; _Pragma("unroll") for (int ci = 0; ci < 4; ++ci) { *(LAS u32x4*)(base + ci * CB + tid * 16) = g[ci]; *(LAS u32x4*)(base + ci * CB + 8192 + tid * 16) = s[ci]; } \
        if (tid < 64) *(LAS f32x4*)(base + (tid >> 4) * CB + 16384 + (tid & 15) * 16) = wreg; } while (0)
    SB_ISSUE(0); SB_COMMIT(0); __syncthreads();
    f32x4 st[4] = {ZERO4, ZERO4, ZERO4, ZERO4};
    for (int r = 0; r < 32; ++r) {
        if (r + 1 < 32) SB_ISSUE(r + 1);
        if (wv < 4) {
            const LAS unsigned char* base = lds + (r & 1) * HB;
#pragma unroll
            for (int ci = 0; ci < 4; ++ci) { const LAS unsigned char* cbp = base + ci * CB; const size_t item = (size_t)bh * 128 + r * 4 + ci;
                bf16x8 bfr[2];
#pragma unroll
                for (int s2 = 0; s2 < 2; ++s2) { u32x4 o; o.x = pk2(st[2 * s2][0], st[2 * s2][1]); o.y = pk2(st[2 * s2][2], st[2 * s2][3]); o.z = pk2(st[2 * s2 + 1][0], st[2 * s2 + 1][1]); o.w = pk2(st[2 * s2 + 1][2], st[2 * s2 + 1][3]); bfr[s2] = __builtin_bit_cast(bf16x8, o); }
#pragma unroll
                for (int mt = 0; mt < 4; ++mt) { const u32x4 bw = __builtin_bit_cast(u32x4, bfr[mt >> 1]); u32x2 o; o.x = (mt & 1) ? bw.z : bw.x; o.y = (mt & 1) ? bw.w : bw.y;
                    if (!DRY) *(u32x2*)(SPP + item * 4096 + ((vb * 4 + mt) * 64 + lane) * 4) = o; }
#pragma unroll
                for (int mt = 0; mt < 4; ++mt) {
                    const bf16x8 a0 = *(const LAS bf16x8*)(cbp + ((mt * 2 + 0) * 64 + lane) * 16), a1 = *(const LAS bf16x8*)(cbp + ((mt * 2 + 1) * 64 + lane) * 16);
                    const u32x2 sp = *(const LAS u32x2*)(cbp + 8192 + ((vb * 4 + mt) * 64 + lane) * 8); const f32x4 w = *(const LAS f32x4*)(cbp + 16384 + (mt * 16 + q4 * 4) * 4);
                    f32x4 acc = ZERO4;
                    acc = __builtin_amdgcn_mfma_f32_16x16x32_bf16(a0, bfr[0], acc, 0, 0, 0); acc = __builtin_amdgcn_mfma_f32_16x16x32_bf16(a1, bfr[1], acc, 0, 0, 0);
                    const f32x4 spv = (f32x4){bf2f(sp.x & 0xffffu), __uint_as_float(sp.x & 0xffff0000u), bf2f(sp.y & 0xffffu), __uint_as_float(sp.y & 0xffff0000u)};
                    st[mt] = acc + w * st[mt] + spv; }
            }
        }
        if (r + 1 < 32) SB_COMMIT((r + 1) & 1);
        __syncthreads();
    }
    if (DRY && wv < 4) { float* dump = (float*)(p->ws + WS_WC + 2 * MiB) + ((size_t)bh * 4 + vb) * 1024 + lane * 16;
#pragma unroll
        for (int mt = 0; mt < 4; ++mt) *(f32x4*)(dump + mt * 4) = st[mt]; }
#undef SB_ISSUE
#undef SB_COMMIT
}

__device__ __forceinline__ void phase_scanC(CP p, LAS unsigned char* lds) {
    const int tid = fresh_tid(), lane = tid & 63, wv = tid >> 6, l15 = lane & 15, q4 = lane >> 4, it = wv >> 1, jt0 = (wv & 1) * 2;
    const bf16_t* SPP = (const bf16_t*)(p->ws + WS_SPP); const bf16_t* LA = (const bf16_t*)(p->ws + WS_LA); const bf16_t* WL2 = (const bf16_t*)(p->ws + WS_WL2); bf16_t* ORW = (bf16_t*)(p->ws + WS_ORW);
    const float* gn_w = p->in[19]; const float* gn_b = p->in[20];
    LAS float* YT = (LAS float*)(lds + SC_CUM); LAS float* BS = (LAS float*)(lds + SC_BS);
    const int tt = tid >> 3, c8 = (tid & 7) * 8;
    const int bh = blockIdx.x >> 3, b = bh >> 4, h = bh & 15, cb = blockIdx.x & 7, ch = h * 64 + c8;
    ScanConst K; ScanLoads L;
    scan_consts(p, lds, K, h); scan_issue(p, L, b, h, cb); scan_stage_x(lds, L); __syncthreads();
    for (int i = 0; i < 16; ++i) {
        const int c = cb + 8 * i, item = bh * 128 + c;
        const size_t m = (size_t)b * S + c * 64 + tt;
        const u32x2 sc0 = *(const u32x2*)(SPP + (size_t)item * 4096 + (size_t)tid * 4), sc1 = *(const u32x2*)(SPP + (size_t)item * 4096 + (size_t)(tid + 512) * 4);
        u32x4 tmv = (u32x4){0u, 0u, 0u, 0u};
        if (tid < 384) { int bo, lo; tm_piece(tid, bo, lo); tmv = *(const u32x4*)(tm_blob(p->ws, item) + bo); }
        scan_front<3>(p, lds, K, L, b, h, i < 15 ? c + 8 : -1, item, sc0, sc1, tmv);
        const u32x4 xg0 = *(const u32x4*)(LA + m * 256 + 128 + c8), xg1 = *(const u32x4*)(LA + m * 256 + 192 + c8);
        const u32x4 gw0 = *(const u32x4*)(WL2 + (size_t)(h * 64 + tt) * 128 + c8), gw1 = *(const u32x4*)(WL2 + (size_t)(h * 64 + tt) * 128 + 64 + c8);
        const LAS bf16_t* ARBS = (const LAS bf16_t*)(lds + SC_CUM);
        { const int half = wv >> 2, it0 = ((wv & 3) >> 1) * 2, jtb = (wv & 1) * 2; f32x4 acc[2][2];
          if (half == 0) { FOR_AC { BLK_IJ; acc[a][c] = (f32x4){bf2f((unsigned)SLOT(3)[(j0 + 0) * LD + i]), bf2f((unsigned)SLOT(3)[(j0 + 1) * LD + i]), bf2f((unsigned)SLOT(3)[(j0 + 2) * LD + i]), bf2f((unsigned)SLOT(3)[(j0 + 3) * LD + i])}; }
              if (jtb == 0) mm_block_1s<false, true>(SLOT(7), ARBS, it0, jtb, 0, l15, q4, acc); else mm_block<false, true>(SLOT(7), ARBS, it0, jtb, l15, q4, acc);
              FOR_AC { BLK_IJ; st4bf(SLOT(11) + i * LD + j0, acc[a][c]); } }
          else { TRI_MM(SLOT(9), ARBS, [&](int i_, int j_) { return ld4bf(SLOT(8) + i_ * LD + j_); }, [&](int i_, int j_, f32x4 v_) { st4bf(SLOT(12) + i_ * LD + j_, v_); }); } }
        __syncthreads();
        { f32x4 acc[2] = {ZERO4, ZERO4}; mm_row<false, true>(SLOT(10), SLOT(11), it, jt0, l15, q4, acc);
          if (jt0 == 0) mm_row_1s<true, true>(SLOT(6), SLOT(12), it, jt0, 0, l15, q4, acc); else mm_row<true, true>(SLOT(6), SLOT(12), it, jt0, l15, q4, acc);
#pragma unroll
          for (int c = 0; c < 2; ++c) { const int i2 = it * 16 + l15, j0 = (jt0 + c) * 16 + q4 * 4;
#pragma unroll
              for (int e = 0; e < 4; ++e) YT[(j0 + e) * 64 + i2] = acc[c][e]; } }
        *(LAS u32x4*)(SLOT(7) + tt * LD + c8) = xg0; *(LAS u32x4*)(SLOT(8) + tt * LD + c8) = xg1;
        *(LAS u32x4*)(SLOT(0) + tt * LD + c8) = gw0; *(LAS u32x4*)(SLOT(9) + tt * LD + c8) = gw1;
        __syncthreads();
        { f32x4 acc[2] = {ZERO4, ZERO4}; mm_row<false, false>(SLOT(7), SLOT(0), it, jt0, l15, q4, acc); mm_row<false, false>(SLOT(8), SLOT(9), it, jt0, l15, q4, acc);
#pragma unroll
          for (int c = 0; c < 2; ++c) st4bf(SLOT(11) + (it * 16 + l15) * LD + (jt0 + c) * 16 + q4 * 4, acc[c]); }
        __syncthreads();
        {
            float y[8], g[8], vv[8], o[8], gnw[8], gnb[8];
            *(f32x4*)gnw = *(const f32x4*)(gn_w + ch); *(f32x4*)(gnw + 4) = *(const f32x4*)(gn_w + ch + 4); *(f32x4*)gnb = *(const f32x4*)(gn_b + ch); *(f32x4*)(gnb + 4) = *(const f32x4*)(gn_b + ch + 4);
            *(f32x4*)y = *(const LAS f32x4*)(YT + tt * 64 + c8); *(f32x4*)(y + 4) = *(const LAS f32x4*)(YT + tt * 64 + c8 + 4);
            *(f32x4*)g = ld4bf(SLOT(11) + tt * LD + c8); *(f32x4*)(g + 4) = ld4bf(SLOT(11) + tt * LD + c8 + 4);
            unpack8(*(const LAS u32x4*)(SLOT(6) + tt * LD + c8), vv);
            float sm = 0.f;
#pragma unroll
            for (int e = 0; e < 8; ++e) sm += y[e];
            const float mean = red8(sm) * (1.f / 64.f); float sq = 0.f;
#pragma unroll
            for (int e = 0; e < 8; ++e) { y[e] -= mean; sq += y[e] * y[e]; }
            const float rstd = __builtin_amdgcn_rsqf(red8(sq) * (1.f / 64.f) + GN_EPS), bs = BS[tt];
#pragma unroll
            for (int e = 0; e < 8; ++e) o[e] = (y[e] * rstd * gnw[e] + gnb[e] + bs * vv[e]) * g[e];
            *(u32x4*)(ORW + m * 1024 + ch) = pack8(o);
        }
        if (i < 15) scan_stage_x(lds, L);
        __syncthreads();
    }
}

__global__ void __launch_bounds__(512, 2) fwd_megakernel(Params p_unused) {
    extern __shared__ __attribute__((aligned(16))) unsigned char lds_raw[];
    LAS unsigned char* lds = (LAS unsigned char*)lds_raw;
    volatile LAS unsigned* bst = (volatile LAS unsigned*)(lds + LDS_BYTES - 16);
    if (threadIdx.x < 4) bst[threadIdx.x] = 0u;
    __syncthreads();
    const XcdBarrier gbar = xcd_barrier_post((unsigned*)(get_params()->ws + WS_CTL), bst);
    phase0(get_params(), lds);
    xcd_barrier(gbar);
    phase_wt(get_params(), lds, 0, 0);
    phase_h(get_params());
    xcd_barrier(gbar);
    {
        CP p = get_params(); unsigned char* ws = p->ws;
        FInProj f{(bf16_t*)(ws + WS_QKV), (bf16_t*)(ws + WS_RKV), (bf16_t*)(ws + WS_LRAW), (bf16_t*)p->out};
        run_gemm(lds, (const bf16_t*)(ws + WS_H), 1024, (const bf16_t*)(ws + WS_WIN), 1024, NIN, 1024, f);
    }
    xcd_barrier(gbar);
    phase_attn(get_params(), lds);
    phase_prep(get_params());
    xcd_barrier(gbar);
    phase_scanA(get_params(), lds);
    xcd_barrier(gbar);
    phase_scanB<false>(get_params(), lds);
    if (blockIdx.x >= 32) { phase_combine(get_params(), 32); phase_wt(get_params(), lds, 1, 32); }
    xcd_barrier(gbar);
    phase_scanC(get_params(), lds);
    xcd_barrier(gbar);
    {
        CP p = get_params(); unsigned char* ws = p->ws;
        FM1 f1{(const bf16_t*)p->out, (bf16_t*)(ws + WS_MRG)};
        run_gemm(lds, (const bf16_t*)(ws + WS_OATT), 256, (const bf16_t*)(ws + WS_WBR), 1280, 1024, 256, f1);
        FM2 f2{(const bf16_t*)p->out, (const bf16_t*)(ws + WS_MRG), (bf16_t*)(ws + WS_MERGED)};
        run_gemm(lds, (const bf16_t*)(ws + WS_ORW), 1024, (const bf16_t*)(ws + WS_WBR) + 256, 1280, 1024, 1024, f2);
    }
    xcd_barrier(gbar);
    {   CP p = get_params(); unsigned char* ws = p->ws;
        EpiRow1 e{p->in[0], p->out, (bf16_t*)(ws + WS_H2), (const float*)(ws + WS_MOD), p->in[6], p->in[7], PanelX<2>{(unsigned long long*)(ws + WS_XB1), (unsigned*)(ws + WS_CTL + 16384)}};
        run_gemm_fused(lds, (const bf16_t*)(ws + WS_MERGED), 1024, (const bf16_t*)(ws + WS_WOUT), 1024, 1024, 1024, e); }
    xcd_barrier(gbar);
    {   unsigned char* ws = get_params()->ws; FRelu2 f{(bf16_t*)(ws + WS_FFH), FF};
        run_gemm(lds, (const bf16_t*)(ws + WS_H2), 1024, (const bf16_t*)(ws + WS_WFF1), 1024, FF, 1024, f); }
    xcd_barrier(gbar);
    {   CP p = get_params(); unsigned char* ws = p->ws;
        EpiRow2 e{p->out, (const float*)(ws + WS_MOD), p->in[8], PanelX<1>{(unsigned long long*)(ws + WS_XB2), (unsigned*)(ws + WS_CTL + 32768)}};
        run_gemm_fused(lds, (const bf16_t*)(ws + WS_FFH), FF, (const bf16_t*)(ws + WS_WFF2), FF, 1024, FF, e); }
}

extern "C" void kernel_launch(void* const* d_in, const int* in_sizes, int n_in, void* d_out, int out_size, void* d_ws, size_t ws_size, hipStream_t stream) {
    static int grid = 0;
    if (grid == 0) {
        if (n_in != 25 || out_size != M * D || ws_size < WS_END) { fprintf(stderr, "kernel_launch: unexpected shapes n_in %d out %d ws %zu\n", n_in, out_size, ws_size); grid = -1; return; }
        int dev = 0, cus = 0, per_cu = 0;
        hipGetDevice(&dev); hipDeviceGetAttribute(&cus, hipDeviceAttributeMultiprocessorCount, dev);
        hipFuncSetAttribute((const void*)fwd_megakernel, hipFuncAttributeMaxDynamicSharedMemorySize, LDS_BYTES);
        hipOccupancyMaxActiveBlocksPerMultiprocessor(&per_cu, (const void*)fwd_megakernel, 512, LDS_BYTES);
        if (per_cu < 1) { fprintf(stderr, "kernel_launch: occupancy query says %d blocks per CU\n", per_cu); per_cu = 1; }
        grid = cus * 1;
        if (grid != 256) { fprintf(stderr, "kernel_launch: this kernel's scan passes are laid out for a 256-CU grid, got %d CUs\n", cus); grid = -1; return; }
        fprintf(stderr, "kernel_launch: cus %d per_cu %d grid %d\n", cus, per_cu, grid);
    }
    if (grid < 0) return;
    Params p{};
    for (int i = 0; i < 25; ++i) p.in[i] = (const float*)d_in[i];
    p.out = (float*)d_out; p.ws = (unsigned char*)d_ws;
    if (hipMemsetAsync((char*)d_ws + WS_CTL, 0, CTL_BYTES, stream) != hipSuccess) { fprintf(stderr, "kernel_launch: memset of the barrier words failed\n"); return; }
    hipLaunchKernelGGL(fwd_megakernel, dim3(grid), dim3(512), LDS_BYTES, stream, p);
    const hipError_t e = hipPeekAtLastError();
    if (e != hipSuccess) fprintf(stderr, "launch failed: %s (grid %d)\n", hipGetErrorString(e), grid);
}
```
